# Optimizing an MI355X kernel written in HIP

```python
import math
import jax, jax.numpy as jnp
from jax import lax
import numpy as np

D_MODEL = 1024
BATCH = 8
SEQ = 2048
DEPTH = 2
DEC_BATCH = 32
DEC_SEQ = 1
PAST_LEN = 16384
PAGE_SIZE = 128

GROUP_W = D_MODEL // 4
N_PROJ = 9 * GROUP_W
CONV_A_WIDTH = 31
HEAD_DIM = 64
N_HEADS_B = GROUP_W // HEAD_DIM
DIL_CONFIGS = ((128, 1), (512, 4), (2048, 16))
MAX_WINDOW = max(w for w, _ in DIL_CONFIGS)
Q_BLOCK = 128
ATTN_SCALE = 1.0 / math.sqrt(HEAD_DIM)
CONV_C_WIDTH = 3
POOL_WINDOWS = (2, 4, 8, 16)
POOL_GROUP = GROUP_W // len(POOL_WINDOWS)
POOL_STATE = max(POOL_WINDOWS) - 1
FF_DIM = -(-8 * D_MODEL // (3 * 256)) * 256
EPS = 1e-6
NEG = -1e30

kernel_name = "hybrid_conformer_dilattn_shortconv_pool_step"


def rmsnorm(x, g):
    xf = x.astype(jnp.float32)
    y = xf * lax.rsqrt(jnp.mean(xf * xf, axis=-1, keepdims=True) + EPS)
    return (y * g.astype(jnp.float32)).astype(x.dtype)


def layernorm(x, g, b):
    xf = x.astype(jnp.float32)
    mu = jnp.mean(xf, axis=-1, keepdims=True)
    xc = xf - mu
    y = xc * lax.rsqrt(jnp.mean(xc * xc, axis=-1, keepdims=True) + EPS)
    return (y * g.astype(jnp.float32) + b.astype(jnp.float32)).astype(x.dtype)


def depthwise_causal_conv(xp, w):
    c = xp.shape[-1]
    return lax.conv_general_dilated(xp, w[:, None, :].astype(xp.dtype), window_strides=(1,), padding="VALID",
                                    dimension_numbers=("NWC", "WIO", "NWC"), feature_group_count=c)


def multi_pool(up, pos0):
    n, tot, c = up.shape
    t = tot - POOL_STATE
    uf = up.astype(jnp.float32)
    cs = jnp.concatenate([jnp.zeros((n, 1, c), jnp.float32), jnp.cumsum(uf, axis=1)], axis=1)
    pos = pos0 + jnp.arange(t)
    p1 = POOL_STATE + 1
    outs = []
    for g, w in enumerate(POOL_WINDOWS):
        sl = slice(g * POOL_GROUP, (g + 1) * POOL_GROUP)
        s = cs[:, p1:p1 + t, sl] - cs[:, p1 - w:p1 - w + t, sl]
        cnt = jnp.minimum(w, pos + 1).astype(jnp.float32)[None, :, None]
        outs.append(s / cnt)
    return (jnp.concatenate(outs, axis=-1) - uf[:, POOL_STATE:]).astype(up.dtype)


def band_attn(q, k, v, n_back):
    n, l, h, hd = q.shape
    nb = -(-l // Q_BLOCK)
    lp = nb * Q_BLOCK
    qb = jnp.pad(q, [(0, 0), (0, lp - l), (0, 0), (0, 0)]).reshape(n, nb, Q_BLOCK, h, hd)

    def windows(a):
        ab = jnp.pad(a, [(0, 0), (Q_BLOCK, lp - l), (0, 0), (0, 0)]).reshape(n, nb + 1, Q_BLOCK, h, hd)
        return jnp.concatenate([ab[:, :-1], ab[:, 1:]], axis=2)

    kw, vw = windows(k), windows(v)
    s = jnp.einsum("nbqhd,nbkhd->nbhqk", qb.astype(jnp.float32), kw.astype(jnp.float32)) * ATTN_SCALE
    qi = jnp.arange(Q_BLOCK)[:, None]
    ki = jnp.arange(2 * Q_BLOCK)[None, :] - Q_BLOCK
    rel = qi - ki
    kpos = jnp.arange(nb)[:, None, None] * Q_BLOCK + ki[None]
    mask = (rel >= 0)[None] & (rel <= n_back)[None] & (kpos >= 0)
    s = jnp.where(mask[None, :, None], s, NEG)
    m = jnp.max(s, axis=-1, keepdims=True)
    p = jnp.exp(s - m)
    den = jnp.sum(p, axis=-1)
    o = jnp.einsum("nbhqk,nbkhd->nbqhd", p, vw.astype(jnp.float32))
    den_t = jnp.moveaxis(den, 2, 3)
    lse_t = jnp.moveaxis(m[..., 0] + jnp.log(den), 2, 3)
    o = o / den_t[..., None]
    return o.reshape(n, lp, h, hd)[:, :l], lse_t.reshape(n, lp, h)[:, :l]


def combine_by_denominator(outs, lses):
    w = jax.nn.softmax(jnp.stack(lses, axis=0), axis=0)
    return jnp.einsum("cnth,cnthd->nthd", w, jnp.stack(outs, axis=0))


def dilated_attn_prompt(q, k, v):
    n, s, h, hd = q.shape
    outs, lses = [], []
    for window, dil in DIL_CONFIGS:
        l = s // dil

        def to_sub(a):
            return a.reshape(n, l, dil, h, hd).transpose(0, 2, 1, 3, 4).reshape(n * dil, l, h, hd)

        o, lse = band_attn(to_sub(q), to_sub(k), to_sub(v), window // dil)
        outs.append(o.reshape(n, dil, l, h, hd).transpose(0, 2, 1, 3, 4).reshape(n, s, h, hd))
        lses.append(lse.reshape(n, dil, l, h).transpose(0, 2, 1, 3).reshape(n, s, h))
    return combine_by_denominator(outs, lses)


def dilated_attn_sample(q, kc, vc, buf_len):
    t = q.shape[1]
    qf = q.astype(jnp.float32)
    outs, lses = [], []
    for window, dil in DIL_CONFIGS:
        nk = window // dil + 1
        idx = buf_len + jnp.arange(t)[:, None] - jnp.arange(nk)[None, :] * dil
        valid = idx >= 0
        idc = jnp.maximum(idx, 0)
        kg = jnp.take(kc, idc, axis=1).astype(jnp.float32)
        vg = jnp.take(vc, idc, axis=1).astype(jnp.float32)
        s = jnp.einsum("nthd,ntkhd->nthk", qf, kg) * ATTN_SCALE
        s = jnp.where(valid[None, :, None, :], s, NEG)
        m = jnp.max(s, axis=-1, keepdims=True)
        p = jnp.exp(s - m)
        den = jnp.sum(p, axis=-1)
        o = jnp.einsum("nthk,ntkhd->nthd", p, vg) / den[..., None]
        outs.append(o)
        lses.append(m[..., 0] + jnp.log(den))
    return combine_by_denominator(outs, lses)


def hybrid_mixer(h, pos0, kbuf, vbuf, abuf, cbuf, pbuf, w_in, conv_a_w, conv_a_b, ln_a_g, ln_a_b,
                 conv_c_w, pool_w, pool_scale, w_out):
    n, t, _ = h.shape
    proj = h @ w_in
    a_val, a_gate, q, k, v, c_x, c_b, c_c, d_u = jnp.split(proj, 9, axis=-1)
    ga = a_val * jax.nn.sigmoid(a_gate)
    ap = jnp.concatenate([abuf, ga], axis=1)
    ya = depthwise_causal_conv(ap, conv_a_w) + conv_a_b
    ya = jax.nn.silu(layernorm(ya, ln_a_g, ln_a_b))
    new_a = ap[:, -(CONV_A_WIDTH - 1):]
    q = q.reshape(n, t, N_HEADS_B, HEAD_DIM)
    k = k.reshape(n, t, N_HEADS_B, HEAD_DIM)
    v = v.reshape(n, t, N_HEADS_B, HEAD_DIM)
    if kbuf is None:
        ob = dilated_attn_prompt(q, k, v)
        keep = min(MAX_WINDOW, t)
        new_k, new_v = k[:, t - keep:], v[:, t - keep:]
    else:
        buf_len = kbuf.shape[1]
        kc = jnp.concatenate([kbuf, k], axis=1)
        vc = jnp.concatenate([vbuf, v], axis=1)
        ob = dilated_attn_sample(q, kc, vc, buf_len)
        new_k, new_v = kc[:, -buf_len:], vc[:, -buf_len:]
    ob = ob.reshape(n, t, GROUP_W).astype(h.dtype)
    cp = jnp.concatenate([cbuf, c_c * c_x], axis=1)
    yc = c_b * depthwise_causal_conv(cp, conv_c_w)
    new_c = cp[:, -(CONV_C_WIDTH - 1):]
    pp = jnp.concatenate([pbuf, d_u], axis=1)
    yd = multi_pool(pp, pos0).reshape(n, t, len(POOL_WINDOWS), POOL_GROUP)
    yd = jnp.einsum("ntgc,gce->ntge", yd, pool_w).reshape(n, t, GROUP_W) * pool_scale
    new_p = pp[:, -POOL_STATE:]
    mix = jnp.concatenate([ya, ob, yc, yd], axis=-1) @ w_out
    return mix, (new_k, new_v, new_a, new_c, new_p)


def swiglu(h, w_gu, w_down):
    g, u = jnp.split(h @ w_gu, 2, axis=-1)
    return (jax.nn.silu(g) * u) @ w_down


def trunk(x, pos0, caches, w_in, conv_a_w, conv_a_b, ln_a_g, ln_a_b, conv_c_w, pool_w, pool_scale,
          w_out, norm1_g, norm2_g, w_gu, w_down, final_g):
    n = x.shape[0]
    new = ([], [], [], [], [])
    for l in range(DEPTH):
        if caches is None:
            kb = vb = None
            ab = jnp.zeros((n, CONV_A_WIDTH - 1, GROUP_W), x.dtype)
            cb = jnp.zeros((n, CONV_C_WIDTH - 1, GROUP_W), x.dtype)
            pb = jnp.zeros((n, POOL_STATE, GROUP_W), x.dtype)
        else:
            kb, vb, ab, cb, pb = caches[0][l], caches[1][l], caches[2][l], caches[3][l], caches[4][l]
        h = rmsnorm(x, norm1_g[l])
        mix, st = hybrid_mixer(h, pos0, kb, vb, ab, cb, pb, w_in[l], conv_a_w[l], conv_a_b[l], ln_a_g[l],
                               ln_a_b[l], conv_c_w[l], pool_w[l], pool_scale[l], w_out[l])
        x = x + mix
        x = x + swiglu(rmsnorm(x, norm2_g[l]), w_gu[l], w_down[l])
        for lst, s in zip(new, st):
            lst.append(s)
    y = rmsnorm(x, final_g)
    return y, [jnp.stack(s, axis=0) for s in new]


def setup_inputs(seed: int = 0) -> dict:
    key = jax.random.key(seed)
    ks = jax.random.split(key, 24)
    f32 = jnp.float32
    buf_s = min(MAX_WINDOW, PAST_LEN)
    nrm = lambda k, shape, sc: jax.random.normal(k, shape, f32) * sc
    return {
        "x_prompt": nrm(ks[0], (BATCH, SEQ, D_MODEL), 1.0),
        "x_sample": nrm(ks[1], (DEC_BATCH, DEC_SEQ, D_MODEL), 1.0),
        "cache_win_k": nrm(ks[2], (DEPTH, DEC_BATCH, buf_s, N_HEADS_B, HEAD_DIM), 1.0),
        "cache_win_v": nrm(ks[3], (DEPTH, DEC_BATCH, buf_s, N_HEADS_B, HEAD_DIM), 1.0),
        "state_conv_a": nrm(ks[4], (DEPTH, DEC_BATCH, CONV_A_WIDTH - 1, GROUP_W), 0.5),
        "state_conv_c": nrm(ks[5], (DEPTH, DEC_BATCH, CONV_C_WIDTH - 1, GROUP_W), 1.0),
        "state_pool": nrm(ks[6], (DEPTH, DEC_BATCH, POOL_STATE, GROUP_W), 1.0),
        "w_in": nrm(ks[7], (DEPTH, D_MODEL, N_PROJ), D_MODEL ** -0.5),
        "conv_a_w": nrm(ks[8], (DEPTH, CONV_A_WIDTH, GROUP_W), CONV_A_WIDTH ** -0.5),
        "conv_a_b": nrm(ks[9], (DEPTH, GROUP_W), 0.02),
        "ln_a_g": 1.0 + nrm(ks[10], (DEPTH, GROUP_W), 0.02),
        "ln_a_b": nrm(ks[11], (DEPTH, GROUP_W), 0.02),
        "conv_c_w": nrm(ks[12], (DEPTH, CONV_C_WIDTH, GROUP_W), CONV_C_WIDTH ** -0.5),
        "pool_w": nrm(ks[13], (DEPTH, len(POOL_WINDOWS), POOL_GROUP, POOL_GROUP), POOL_GROUP ** -0.5),
        "pool_scale": 1.0 + nrm(ks[14], (DEPTH, GROUP_W), 0.02),
        "w_out": nrm(ks[15], (DEPTH, D_MODEL, D_MODEL), D_MODEL ** -0.5),
        "norm1_g": 1.0 + nrm(ks[16], (DEPTH, D_MODEL), 0.02),
        "norm2_g": 1.0 + nrm(ks[17], (DEPTH, D_MODEL), 0.02),
        "w_gu": nrm(ks[18], (DEPTH, D_MODEL, 2 * FF_DIM), D_MODEL ** -0.5),
        "w_down": nrm(ks[19], (DEPTH, FF_DIM, D_MODEL), FF_DIM ** -0.5),
        "final_g": 1.0 + nrm(ks[20], (D_MODEL,), 0.02),
    }


def reference(x_prompt, x_sample, cache_win_k, cache_win_v, state_conv_a, state_conv_c, state_pool,
              w_in, conv_a_w, conv_a_b, ln_a_g, ln_a_b, conv_c_w, pool_w, pool_scale, w_out,
              norm1_g, norm2_g, w_gu, w_down, final_g):
    y_prompt, st_p = trunk(x_prompt, 0, None, w_in, conv_a_w, conv_a_b, ln_a_g, ln_a_b, conv_c_w, pool_w,
                           pool_scale, w_out, norm1_g, norm2_g, w_gu, w_down, final_g)
    caches = (cache_win_k, cache_win_v, state_conv_a, state_conv_c, state_pool)
    y_sample, st_s = trunk(x_sample, PAST_LEN, caches, w_in, conv_a_w, conv_a_b, ln_a_g, ln_a_b, conv_c_w,
                           pool_w, pool_scale, w_out, norm1_g, norm2_g, w_gu, w_down, final_g)
    k_p, v_p, a_p, c_p, p_p = st_p
    k_s, v_s, a_s, c_s, p_s = st_s
    return (y_prompt, y_sample, k_p, v_p, a_p, c_p, p_p, k_s, v_s, a_s, c_s, p_s)
```

```cpp
#include <hip/hip_runtime.h>
#include <cstdio>
#include <cstdint>

constexpr int DM = 1024, NPROJ = 2304, FFD = 2816, NGU = 5632, GW = 256;
constexpr int NB = 8, SEQ = 2048, MP = NB * SEQ, MS = 32, MPAD = 16640, DEPTH = 2, BUF = 2048;
constexpr float EPSN = 1e-6f;
constexpr int C_AV = 0, C_AG = 256, C_Q = 512, C_K = 768, C_V = 1024, C_CX = 1280, C_CB = 1536, C_CC = 1792, C_DU = 2048;
constexpr size_t O_Y = 0, O_YS = 16777216, O_KP = 16809984, O_VP = 25198592, O_AP = 33587200, O_CP = 33710080, O_PP = 33718272,
                 O_KS = 33779712, O_VS = 67334144, O_AS = 100888576, O_CS = 101380096, O_PS = 101412864, O_END = 101658624;
namespace pg8 {
#define PG8_LAS __attribute__((address_space(3)))
typedef unsigned short bf16_t;
typedef short bf16x8 __attribute__((ext_vector_type(8)));
typedef float f32x4 __attribute__((ext_vector_type(4)));
typedef unsigned u32x4 __attribute__((ext_vector_type(4)));
constexpr int BM = 256, BK = 64, HALF = 128, HTB = HALF * BK * 2  , STAGE_BYTES = 8 * HTB, NXCD = 8, WGM = 8;

__host__ __device__ __forceinline__ int lds_byte(int r, int c) { const int st = (r >> 4) * 2 + (c >> 5), rr = r & 15, cc = c & 31, ob = rr * 64 + cc * 2; return st * 1024 + (ob ^ (((ob >> 9) & 1) << 5)); }
__host__ __device__ __forceinline__ void stage_rc(int b, int& R, int& C) { const int st = b / 1024, sb = b % 1024, swz = sb ^ (((sb >> 9) & 1) << 5); R = (st >> 1) * 16 + swz / 64; C = (st & 1) * 32 + (swz % 64) / 2; }
__host__ __device__ __forceinline__ int perm32(int rho) { const int n = rho >> 4, i = rho & 15; return 8 * (i >> 2) + 4 * n + (i & 3); }

struct Unit { int pm, pn; };
struct Gemm { const bf16_t* A; const bf16_t* Bt; int M, N, K; };

struct StaticOrder {
    int nM, nN, nwg, G, c;
    __host__ __device__ void init(int M, int N, int G_, int c_) { nM = M / BM; nN = N / BM; nwg = nM * nN; G = G_; c = c_; }
    __host__ __device__ bool next(int i, Unit& u) const {
        const long L = (long)i * G + c; if (L >= nwg) return false;
        int wgid = (int)L; { const int q = nwg / NXCD, r = nwg % NXCD, xcd = wgid % NXCD, off = wgid / NXCD; wgid = (xcd < r ? xcd * (q + 1) : r * (q + 1) + (xcd - r) * q) + off; }
        const int nig = WGM * nN, gid = wgid / nig, fm = gid * WGM, gsz = (nM - fm) < WGM ? (nM - fm) : WGM;
        u.pm = fm + ((wgid % nig) % gsz); u.pn = (wgid % nig) / gsz; return true;
    }
    __device__ __forceinline__ void a_ready(const Unit&) const {}
    __device__ __forceinline__ void done(const Unit&) const {}
};
__device__ __forceinline__ unsigned cvt_pk_bf16(float lo, float hi) { unsigned r; asm volatile("v_cvt_pk_bf16_f32 %0, %1, %2" : "=v"(r) : "v"(lo), "v"(hi)); return r; }
typedef float f32x2 __attribute__((ext_vector_type(2)));
__device__ __forceinline__ float row_rs(const float* part, int row, int fq) {
    const f32x4 p = *(const f32x4*)(part + (size_t)row * 16 + 4 * fq);
    float s = (p[0] + p[1]) + (p[2] + p[3]);
    s += __shfl_xor(s, 16); s += __shfl_xor(s, 32);
    return __builtin_amdgcn_rsqf(s * (1.0f / 1024.0f) + 1e-6f);
}
struct EpiProj {
    static constexpr bool PERM = true, AFTER_DRAIN = false;
    bf16_t* proj; const float* part; float* kp; float* vp; float* ks; float* vs; int mp, ldp;
    __device__ __forceinline__ void operator()(const f32x4 (&acc)[2][2][4][2], const Unit& u, int wr, int wc, int fr, int fq) const {
        const int row0 = u.pm * BM + wr * 64 + fr, cw = wc * 32 + 8 * fq;
        const bool iskv = (u.pn == 3) || (u.pn == 4);
        float* kvp = (u.pn == 3) ? kp : vp; float* kvs = (u.pn == 3) ? ks : vs;
#pragma unroll
        for (int ai = 0; ai < 2; ++ai)
#pragma unroll
            for (int m = 0; m < 4; ++m) {
                const int row = row0 + ai * HALF + m * 16;
                const float r = row_rs(part, row, fq);
                bf16_t* rowp = proj + (size_t)row * ldp + u.pn * BM + cw;
#pragma unroll
                for (int bj = 0; bj < 2; ++bj) {
                    const f32x4 v0 = acc[ai][bj][m][0] * r, v1 = acc[ai][bj][m][1] * r;
                    u32x4 w; w.x = cvt_pk_bf16(v0[0], v0[1]); w.y = cvt_pk_bf16(v0[2], v0[3]); w.z = cvt_pk_bf16(v1[0], v1[1]); w.w = cvt_pk_bf16(v1[2], v1[3]);
                    *(u32x4*)(rowp + bj * HALF) = w;
                    if (iskv) {
                        const int c = bj * HALF + cw;
                        if (row < mp) { float* d = kvp + (size_t)row * 256 + c; *(f32x4*)d = v0; *(f32x4*)(d + 4) = v1; }
                        else if (row < mp + 32) { float* d = kvs + ((size_t)(row - mp) * 2048 + 2047) * 256 + c; *(f32x4*)d = v0; *(f32x4*)(d + 4) = v1; }
                    }
                }
            }
    }
};
struct EpiRes {
    static constexpr bool PERM = true, AFTER_DRAIN = false;
    const float* basep; const float* bases; float* X; bf16_t* xnb; float* part; int mp;
    __device__ __forceinline__ void operator()(const f32x4 (&acc)[2][2][4][2], const Unit& u, int wr, int wc, int fr, int fq) const {
        const int row0 = u.pm * BM + wr * 64 + fr, colt = u.pn * BM + wc * 32 + 8 * fq;
#pragma unroll
        for (int ai = 0; ai < 2; ++ai)
#pragma unroll
            for (int m = 0; m < 4; ++m) {
                const int row = row0 + ai * HALF + m * 16;
                const float* bp = row < mp ? basep + (size_t)row * 1024 : (row < mp + 32 ? bases + (size_t)(row - mp) * 1024 : nullptr);
                float ss = 0.f;
#pragma unroll
                for (int bj = 0; bj < 2; ++bj) {
                    const int c = colt + bj * HALF;
                    f32x4 v0 = acc[ai][bj][m][0], v1 = acc[ai][bj][m][1];
                    if (bp) { v0 += *(const f32x4*)(bp + c); v1 += *(const f32x4*)(bp + c + 4); }
                    float* xo = X + (size_t)row * 1024 + c; *(f32x4*)xo = v0; *(f32x4*)(xo + 4) = v1;
                    u32x4 w; w.x = cvt_pk_bf16(v0[0], v0[1]); w.y = cvt_pk_bf16(v0[2], v0[3]); w.z = cvt_pk_bf16(v1[0], v1[1]); w.w = cvt_pk_bf16(v1[2], v1[3]);
                    *(u32x4*)(xnb + (size_t)row * 1024 + c) = w;
                    ss += (v0[0] * v0[0] + v0[1] * v0[1]) + (v0[2] * v0[2] + v0[3] * v0[3]) + (v1[0] * v1[0] + v1[1] * v1[1]) + (v1[2] * v1[2] + v1[3] * v1[3]);
                }
                ss += __shfl_xor(ss, 16); ss += __shfl_xor(ss, 32);
                if (fq == 0) part[(size_t)row * 16 + u.pn * 4 + wc] = ss;
            }
    }
};
struct EpiSwiGLU {
    static constexpr bool PERM = true, AFTER_DRAIN = false;
    bf16_t* act; const float* part; int lda;
    __device__ __forceinline__ void operator()(const f32x4 (&acc)[2][2][4][2], const Unit& u, int wr, int wc, int fr, int fq) const {
        const int row0 = u.pm * BM + wr * 64 + fr, colt = u.pn * HALF + wc * 32 + 8 * fq;
#pragma unroll
        for (int ai = 0; ai < 2; ++ai)
#pragma unroll
            for (int m = 0; m < 4; ++m) {
                const int row = row0 + ai * HALF + m * 16;
                const float r = row_rs(part, row, fq);
                float o[8];
#pragma unroll
                for (int n = 0; n < 2; ++n)
#pragma unroll
                    for (int j = 0; j < 4; ++j) {
                        const float g = acc[ai][0][m][n][j] * r, uu = acc[ai][1][m][n][j] * r;
                        o[4 * n + j] = g * __builtin_amdgcn_rcpf(1.0f + __expf(-g)) * uu;
                    }
                u32x4 w; w.x = cvt_pk_bf16(o[0], o[1]); w.y = cvt_pk_bf16(o[2], o[3]); w.z = cvt_pk_bf16(o[4], o[5]); w.w = cvt_pk_bf16(o[6], o[7]);
                *(u32x4*)(act + (size_t)row * lda + colt) = w;
            }
    }
};

template <class Epi, class Sched, bool ALIGN_EPI = false, bool SP2 = false>
__device__ __forceinline__ void gemm_phase(PG8_LAS unsigned char* lds, const Gemm g, const Sched& S, const Epi& E, const int tid) {
    const int wid = __builtin_amdgcn_readfirstlane(tid >> 6), lane = tid & 63, wr = wid >> 2, wc = wid & 3, fr = lane & 15, fq = lane >> 4;
    const int K = g.K, nt = K / BK;
    unsigned voffA[2], voffB[2];
#pragma unroll
    for (int i = 0; i < 2; ++i) { int R, C; stage_rc(tid * 16 + i * 8192, R, C); const int Rb = Epi::PERM ? ((R & ~31) + perm32(R & 31)) : R;
        voffA[i] = (unsigned)(R * K + C) * 2u; voffB[i] = (unsigned)(Rb * K + C) * 2u; }
    const size_t kstep = (size_t)(BK * 2);
    const size_t hstep = (size_t)HALF * K * 2;
    const size_t tstep = 2 * hstep;
    const unsigned ldsw = (unsigned)wid * 1024u;
    const int aoff = lds_byte(wr * 64 + fr, fq * 8), boff = lds_byte(wc * 32 + fr, fq * 8);
#define PG8_SA(b, h) (((b) * 2 + (h)) * HTB)
#define PG8_SB(b, h) ((4 + (b) * 2 + (h)) * HTB)
#define PG8_STAGE(bufoff, gbase, voff) do { _Pragma("unroll") for (int _i = 0; _i < 2; ++_i) \
        __builtin_amdgcn_global_load_lds((const unsigned*)((const char*)(gbase) + (voff)[_i]), (PG8_LAS unsigned*)(lds + (bufoff) + ldsw + _i * 8192), 16, 0, 0); } while (0)
#define PG8_LDA(dst, b, h) do { _Pragma("unroll") for (int m = 0; m < 4; ++m) _Pragma("unroll") for (int k = 0; k < 2; ++k) dst[m][k] = *(const PG8_LAS bf16x8*)(lds + PG8_SA(b, h) + aoff + m * 2048 + k * 1024); } while (0)
#define PG8_LDB(dst, b, h) do { _Pragma("unroll") for (int n = 0; n < 2; ++n) _Pragma("unroll") for (int k = 0; k < 2; ++k) dst[n][k] = *(const PG8_LAS bf16x8*)(lds + PG8_SB(b, h) + boff + n * 2048 + k * 1024); } while (0)
#define PG8_MMA(ai, bj, At, Bt) do { __builtin_amdgcn_s_setprio(1); _Pragma("unroll") for (int m = 0; m < 4; ++m) _Pragma("unroll") for (int n = 0; n < 2; ++n) _Pragma("unroll") for (int k = 0; k < 2; ++k) \
        acc[ai][bj][m][n] = __builtin_amdgcn_mfma_f32_16x16x32_bf16(Bt[n][k], At[m][k], acc[ai][bj][m][n], 0, 0, 0); __builtin_amdgcn_s_setprio(0); } while (0)
#define PG8_WAIT_V(n) asm volatile("s_waitcnt vmcnt(" #n ")" ::: "memory")
#define PG8_WAIT_L(n) asm volatile("s_waitcnt lgkmcnt(" #n ")" ::: "memory")
#define PG8_BAR __builtin_amdgcn_s_barrier()
#define PG8_SCHED __builtin_amdgcn_sched_barrier(0)
    Unit cur, nxt; int ui = 0;
    if (!S.next(0, cur)) return;
    f32x4 acc[2][2][4][2];
#pragma unroll
    for (int a = 0; a < 2; ++a)
#pragma unroll
        for (int b = 0; b < 2; ++b)
#pragma unroll
            for (int m = 0; m < 4; ++m)
#pragma unroll
                for (int n = 0; n < 2; ++n) acc[a][b][m][n] = (f32x4){0.f, 0.f, 0.f, 0.f};
    bf16x8 At[4][2], B0[2][2], B1[2][2];
    const char* cA = (const char*)g.A + (size_t)cur.pm * tstep; const char* cB = (const char*)g.Bt + (size_t)cur.pn * tstep;
    S.a_ready(cur);
    if constexpr (SP2) {
        PG8_STAGE(PG8_SB(0, 0), cB, voffB); PG8_STAGE(PG8_SB(0, 1), cB + hstep, voffB); PG8_STAGE(PG8_SA(0, 0), cA, voffA); PG8_STAGE(PG8_SA(0, 1), cA + hstep, voffA);
        if (wr == 1) PG8_BAR;
        PG8_WAIT_V(2); PG8_BAR;
        PG8_STAGE(PG8_SB(1, 0), cB + kstep, voffB); PG8_STAGE(PG8_SA(1, 0), cA + kstep, voffA); PG8_STAGE(PG8_SB(1, 1), cB + hstep + kstep, voffB);
        PG8_WAIT_V(6); PG8_BAR;
    } else {
        PG8_STAGE(PG8_SB(0, 0), cB, voffB); PG8_STAGE(PG8_SA(0, 0), cA, voffA); PG8_STAGE(PG8_SB(0, 1), cB + hstep, voffB); PG8_STAGE(PG8_SA(0, 1), cA + hstep, voffA);
        if (wr == 1) PG8_BAR;
        PG8_WAIT_V(4); PG8_BAR;
        PG8_STAGE(PG8_SB(1, 0), cB + kstep, voffB); PG8_STAGE(PG8_SA(1, 0), cA + kstep, voffA); PG8_STAGE(PG8_SB(1, 1), cB + hstep + kstep, voffB);
        PG8_WAIT_V(6); PG8_BAR;
    }
    for (;;) {
        const bool has_next = S.next(ui + 1, nxt);
        const char* nA = has_next ? (const char*)g.A + (size_t)nxt.pm * tstep : cA; const char* nB = has_next ? (const char*)g.Bt + (size_t)nxt.pn * tstep : cB;
        for (int t = 0; t < nt; t += 2) {
            const bool last = (t == nt - 2);
            const char* a1 = cA + (size_t)(t + 1) * kstep;
            const char* a2 = last ? nA : cA + (size_t)(t + 2) * kstep; const char* b2 = last ? nB : cB + (size_t)(t + 2) * kstep;
            const char* a3 = a2 + kstep; const char* b3 = b2 + kstep;
            if (last && has_next) S.a_ready(nxt);
            if constexpr (SP2) {
            PG8_LDB(B0, 0, 0); PG8_LDB(B1, 0, 1); PG8_SCHED; PG8_LDA(At, 0, 0); PG8_STAGE(PG8_SA(1, 1), a1 + hstep, voffA);
            PG8_WAIT_V(8); PG8_WAIT_L(0); PG8_BAR; PG8_MMA(0, 0, At, B0); PG8_MMA(0, 1, At, B1); PG8_BAR; PG8_SCHED;
            PG8_LDA(At, 0, 1); PG8_STAGE(PG8_SB(0, 0), b2, voffB); PG8_STAGE(PG8_SB(0, 1), b2 + hstep, voffB); PG8_STAGE(PG8_SA(0, 0), a2, voffA);
            PG8_WAIT_V(8); PG8_WAIT_L(0); PG8_BAR; PG8_MMA(1, 0, At, B0); PG8_MMA(1, 1, At, B1); PG8_BAR; PG8_SCHED;
            PG8_LDB(B0, 1, 0); PG8_LDB(B1, 1, 1); PG8_SCHED; PG8_LDA(At, 1, 0); PG8_STAGE(PG8_SA(0, 1), a2 + hstep, voffA);
            PG8_WAIT_V(8); PG8_WAIT_L(0); PG8_BAR; PG8_MMA(0, 0, At, B0); PG8_MMA(0, 1, At, B1); PG8_BAR; PG8_SCHED;
            PG8_LDA(At, 1, 1); PG8_STAGE(PG8_SB(1, 0), b3, voffB); PG8_STAGE(PG8_SB(1, 1), b3 + hstep, voffB); PG8_STAGE(PG8_SA(1, 0), a3, voffA);
            PG8_WAIT_V(8); PG8_WAIT_L(0); PG8_BAR; PG8_MMA(1, 0, At, B0); PG8_MMA(1, 1, At, B1); PG8_BAR; PG8_SCHED;
            } else {
            PG8_LDB(B0, 0, 0); PG8_SCHED; PG8_LDA(At, 0, 0); PG8_STAGE(PG8_SA(1, 1), a1 + hstep, voffA);
            PG8_WAIT_L(8); PG8_BAR; PG8_WAIT_L(0); PG8_MMA(0, 0, At, B0); PG8_BAR; PG8_SCHED;
            PG8_LDB(B1, 0, 1); PG8_STAGE(PG8_SB(0, 0), b2, voffB);
            PG8_BAR; PG8_WAIT_L(0); PG8_MMA(0, 1, At, B1); PG8_BAR;
            PG8_LDA(At, 0, 1); PG8_STAGE(PG8_SA(0, 0), a2, voffA);
            PG8_BAR; PG8_WAIT_L(0); PG8_MMA(1, 0, At, B0); PG8_BAR; PG8_SCHED;
            PG8_STAGE(PG8_SB(0, 1), b2 + hstep, voffB);
            PG8_WAIT_V(6); PG8_BAR; PG8_MMA(1, 1, At, B1); PG8_BAR;
            PG8_LDB(B0, 1, 0); PG8_SCHED; PG8_LDA(At, 1, 0); PG8_STAGE(PG8_SA(0, 1), a2 + hstep, voffA);
            PG8_WAIT_L(8); PG8_BAR; PG8_WAIT_L(0); PG8_MMA(0, 0, At, B0); PG8_BAR; PG8_SCHED;
            PG8_LDB(B1, 1, 1); PG8_STAGE(PG8_SB(1, 0), b3, voffB);
            PG8_BAR; PG8_WAIT_L(0); PG8_MMA(0, 1, At, B1); PG8_BAR;
            PG8_LDA(At, 1, 1); PG8_STAGE(PG8_SA(1, 0), a3, voffA);
            PG8_BAR; PG8_WAIT_L(0); PG8_MMA(1, 0, At, B0); PG8_BAR; PG8_SCHED;
            PG8_STAGE(PG8_SB(1, 1), b3 + hstep, voffB);
            PG8_WAIT_V(6); PG8_BAR; PG8_MMA(1, 1, At, B1); PG8_BAR;
            }
        }
        if constexpr (ALIGN_EPI) { if (wr == 0) PG8_BAR; }
        if constexpr (!Epi::AFTER_DRAIN) { E(acc, cur, wr, wc, fr, fq); S.done(cur); }
        if (!has_next) break;
#pragma unroll
        for (int a = 0; a < 2; ++a)
#pragma unroll
            for (int b = 0; b < 2; ++b)
#pragma unroll
                for (int m = 0; m < 4; ++m)
#pragma unroll
                    for (int n = 0; n < 2; ++n) acc[a][b][m][n] = (f32x4){0.f, 0.f, 0.f, 0.f};
        cur = nxt; cA = nA; cB = nB; ++ui;
        if constexpr (ALIGN_EPI) { if (wr == 1) PG8_BAR; }
    }
    PG8_WAIT_V(0);
    if constexpr (!ALIGN_EPI) { if (wr == 0) PG8_BAR; }
    PG8_BAR;
    if constexpr (Epi::AFTER_DRAIN) { E.fused(acc, cur, wr, wc, fr, fq, lds, wid, lane); S.done(cur); }
#undef PG8_SA
#undef PG8_SB
#undef PG8_STAGE
#undef PG8_LDA
#undef PG8_LDB
#undef PG8_MMA
#undef PG8_WAIT_V
#undef PG8_WAIT_L
#undef PG8_BAR
#undef PG8_SCHED
}
}

constexpr int NWAVES = 8;
constexpr size_t MiB = 1u << 20;
constexpr size_t WS_CTL = 0, CTL_ZERO_BYTES = 1 * MiB;
constexpr size_t WS_PART1 = 1 * MiB, WS_PART2 = 3 * MiB, WS_LSE = 5 * MiB;
constexpr size_t WS_W = 8 * MiB;
constexpr size_t W_IN = 0, W_OUT = (size_t)NPROJ * DM * 2, W_GU = W_OUT + (size_t)DM * DM * 2, W_DN = W_GU + (size_t)NGU * DM * 2, W_LAYER = W_DN + (size_t)DM * FFD * 2;
static_assert(W_LAYER == 23 * MiB, "weights per layer");
constexpr size_t WS_XB = 56 * MiB, WS_X1B = 89 * MiB, WS_MIX = 122 * MiB;
constexpr size_t WS_X = 155 * MiB;
constexpr size_t WS_PROJ = 220 * MiB;
constexpr size_t WS_ATTO = 294 * MiB;
constexpr size_t WS_ACT = 220 * MiB;
constexpr size_t WS_END = 344 * MiB;
static_assert(WS_PROJ + (size_t)MPAD * NPROJ * 2 <= WS_ATTO && WS_ATTO + (size_t)3 * MPAD * 256 * 4 <= WS_END && WS_ACT + (size_t)MPAD * FFD * 2 <= WS_END, "ws map");
static_assert(WS_X + (size_t)MPAD * DM * 4 <= WS_PROJ && WS_MIX + (size_t)MPAD * DM * 2 <= WS_X && WS_W + 2 * W_LAYER <= WS_XB, "ws map 2");
constexpr int CW_BAR = 4096;

constexpr int RING_OFF = 0, RING_BYTES = 131072;
constexpr int LDSCTL_OFF = RING_BYTES, MISC_OFF = LDSCTL_OFF + 320;
constexpr int LDS_BYTES = 147456;

#define GAS __attribute__((address_space(1)))
#define LAS __attribute__((address_space(3)))
typedef unsigned short bf16;
typedef unsigned v4u __attribute__((ext_vector_type(4)));
typedef unsigned v2u __attribute__((ext_vector_type(2)));
typedef float f32x4 __attribute__((ext_vector_type(4)));
typedef float f32x16 __attribute__((ext_vector_type(16)));
typedef short bf16x8 __attribute__((ext_vector_type(8)));
typedef short s16x4 __attribute__((ext_vector_type(4)));
typedef GAS unsigned gu32;
#define LDS_WAIT() asm volatile("s_waitcnt lgkmcnt(0)" ::: "memory")
#define VM_WAIT() asm volatile("s_waitcnt vmcnt(0)" ::: "memory")
__device__ __forceinline__ unsigned f2bf(float f) { unsigned u = __builtin_bit_cast(unsigned, f); return (u + 0x7fffu + ((u >> 16) & 1u)) >> 16; }
__device__ __forceinline__ unsigned pk2(float lo, float hi) { return pg8::cvt_pk_bf16(lo, hi); }
__device__ __forceinline__ float bflo(unsigned w) { return __builtin_bit_cast(float, w << 16); }
__device__ __forceinline__ float bfhi(unsigned w) { return __builtin_bit_cast(float, w & 0xffff0000u); }
__device__ __forceinline__ void unpack8(const v4u w, float* f) { f[0] = bflo(w.x); f[1] = bfhi(w.x); f[2] = bflo(w.y); f[3] = bfhi(w.y); f[4] = bflo(w.z); f[5] = bfhi(w.z); f[6] = bflo(w.w); f[7] = bfhi(w.w); }
__device__ __forceinline__ v4u pack8(const float* f) { v4u w; w.x = pk2(f[0], f[1]); w.y = pk2(f[2], f[3]); w.z = pk2(f[4], f[5]); w.w = pk2(f[6], f[7]); return w; }
__device__ __forceinline__ float sigmoidf_(float x) { return __builtin_amdgcn_rcpf(1.0f + __expf(-x)); }
__device__ __forceinline__ float wave_sum(float v) {
#pragma unroll
    for (int o = 1; o < 64; o <<= 1) v += __shfl_xor(v, o);
    return v;
}
__device__ __forceinline__ float wave_max(float v) {
#pragma unroll
    for (int o = 1; o < 64; o <<= 1) v = fmaxf(v, __shfl_xor(v, o));
    return v;
}

#define XB_TMO      128
#define XB_XCNT(j)  (256  + 64 * (j))
#define XB_XSUB(j)  (1280 + 64 * (j))
#define XB_XGEN(j)  (2304 + 64 * (j))
#define XB_TOP      3328
#define XB_TOPGEN   3392
#define XCD_BAR_WORDS 3456
#define XB_SPIN_CAP (1u << 18)

__device__ __forceinline__ unsigned xb_ld(unsigned* p)              { return __hip_atomic_load(p, __ATOMIC_RELAXED, __HIP_MEMORY_SCOPE_AGENT); }
__device__ __forceinline__ unsigned xb_add(unsigned* p, unsigned v) { return __hip_atomic_fetch_add(p, v, __ATOMIC_RELAXED, __HIP_MEMORY_SCOPE_AGENT); }
__device__ __forceinline__ unsigned xb_xcc_id() { return (unsigned)__builtin_amdgcn_s_getreg((3 << 11) | 20) & 0xFu; }
#define XB_SPIN(cond, bar) do { unsigned _sp = 0; while (cond) { __builtin_amdgcn_s_sleep(1); \
    if ((++_sp & 255u) == 0u) { if (xb_ld(&(bar)[XB_TMO])) break; if (_sp > XB_SPIN_CAP) { atomicAdd(&(bar)[XB_TMO], 1u); break; } } } } while (0)

struct XcdBarrier {
    unsigned* bar; unsigned x;
    volatile LAS unsigned* st;
};
__device__ __forceinline__ XcdBarrier xcd_barrier_post(unsigned* bar, volatile LAS unsigned* st) {
    XcdBarrier b; b.bar = bar; b.x = xb_xcc_id(); b.st = st;
    if (threadIdx.x == 0) (void)xb_add(&bar[XB_XCNT(b.x)], 1u);
    return b;
}
__device__ __forceinline__ void xcd_barrier_complete(unsigned* bar, unsigned x, unsigned& nloc, unsigned& nx) {
    const unsigned G = gridDim.x * gridDim.y * gridDim.z;
    unsigned sum, cnt, mine, sp = 0u;
    for (;;) {
        sum = 0u; cnt = 0u; mine = 0u;
#pragma unroll
        for (unsigned j = 0; j < 16; ++j) { const unsigned c = xb_ld(&bar[XB_XCNT(j)]); sum += c; cnt += (c > 0u) ? 1u : 0u; mine = (j == x) ? c : mine; }
        if (sum == G) break;
        __builtin_amdgcn_s_sleep(1);
        if ((++sp & 255u) == 0u) { if (xb_ld(&bar[XB_TMO])) break; if (sp > XB_SPIN_CAP) { atomicAdd(&bar[XB_TMO], 1u); break; } }
    }
    nloc = mine > 0u ? mine : 1u; nx = cnt > 0u ? cnt : 1u;
}
__device__ __forceinline__ void xcd_barrier(const XcdBarrier& b) {
    asm volatile("s_waitcnt vmcnt(0)" ::: "memory");
    __syncthreads();
    if (threadIdx.x == 0) {
        unsigned* bar = b.bar;
        __builtin_amdgcn_s_waitcnt(0);
        unsigned nloc = b.st[0], nx = b.st[1];
        if (nloc == 0u) { xcd_barrier_complete(bar, b.x, nloc, nx); b.st[0] = nloc; b.st[1] = nx; }
        const unsigned old = xb_add(&bar[XB_XSUB(b.x)], 1u);
        const unsigned gen = old / nloc;
        if (old + 1u == (gen + 1u) * nloc) {
            __builtin_amdgcn_fence(__ATOMIC_RELEASE, "agent");
            asm volatile("s_waitcnt vmcnt(0)" ::: "memory");
            const unsigned og = xb_add(&bar[XB_TOP], 1u);
            const unsigned tg = og / nx;
            if (og + 1u == (tg + 1u) * nx) xb_add(&bar[XB_TOPGEN], 1u);
            else XB_SPIN(xb_ld(&bar[XB_TOPGEN]) == tg, bar);
            __builtin_amdgcn_fence(__ATOMIC_ACQUIRE, "agent");
            xb_add(&bar[XB_XGEN(b.x)], 1u);
            asm volatile("s_waitcnt vmcnt(0)" ::: "memory");
        } else {
            XB_SPIN(xb_ld(&bar[XB_XGEN(b.x)]) == gen, bar);
            __builtin_amdgcn_fence(__ATOMIC_ACQUIRE, "agent");
            asm volatile("s_waitcnt vmcnt(0)" ::: "memory");
        }
    }
    __syncthreads();
}

struct Args { const float* in[21]; float* out; unsigned char* ws; };
typedef __attribute__((address_space(4))) const unsigned char* kaptr_t;
struct Frame {
    LAS unsigned char* lds;
    int tid, lane, wave, G, vcu;
    kaptr_t ka;
    float* out; unsigned char* ws;
    __device__ __forceinline__ const float* inp(int i) const { return *(const float* const __attribute__((address_space(4)))*)(ka + 8 * i); }
};
__device__ __forceinline__ void launder(Frame& F) {
    asm volatile("" : "+s"(F.ka), "+s"(F.G), "+s"(F.vcu), "+v"(F.tid));
    F.lane = F.tid & 63; F.wave = __builtin_amdgcn_readfirstlane(F.tid >> 6);
    F.out = *(float* const __attribute__((address_space(4)))*)(F.ka + 8 * 21);
    F.ws = *(unsigned char* const __attribute__((address_space(4)))*)(F.ka + 8 * 22);
}
enum { I_XP = 0, I_XS, I_CK, I_CV, I_SA, I_SC, I_SP, I_WIN, I_CAW, I_CAB, I_LNG, I_LNB, I_CCW, I_PW, I_PS, I_WOUT, I_N1, I_N2, I_WGU, I_WDN, I_FG };

__device__ __forceinline__ void tr_item(const float* W, int ldw, int k0, int srccol0, const float* ksc, bf16* WT, int K, int dstrow0, LAS float* scr, int lane) {
#pragma unroll 8
    for (int i = 0; i < 32; ++i) { const int kk = 2 * i + (lane >> 5); float v = W[(size_t)(k0 + kk) * ldw + srccol0 + (lane & 31)]; if (ksc) v *= ksc[k0 + kk]; scr[kk * 33 + (lane & 31)] = v; }
    LDS_WAIT(); asm volatile("" ::: "memory");
    const int c = lane & 7;
#pragma unroll
    for (int j = 0; j < 4; ++j) { const int n = (lane >> 3) + 8 * j; const LAS float* s = scr + (8 * c) * 33 + n;
        v4u o; o.x = pk2(s[0 * 33], s[1 * 33]); o.y = pk2(s[2 * 33], s[3 * 33]); o.z = pk2(s[4 * 33], s[5 * 33]); o.w = pk2(s[6 * 33], s[7 * 33]);
        *(GAS v4u*)(WT + (size_t)(dstrow0 + n) * K + k0 + 8 * c) = o; }
    LDS_WAIT(); asm volatile("" ::: "memory");
}
__device__ __forceinline__ void pool_fold_item(const float* wout, const float* pw, const float* ps, bf16* WT, int g, int n0, LAS float* scr, int lane) {
#pragma unroll 8
    for (int i = 0; i < 32; ++i) { const int e = 2 * i + (lane >> 5); scr[e * 33 + (lane & 31)] = wout[(size_t)(768 + g * 64 + e) * DM + n0 + (lane & 31)] * ps[g * 64 + e]; }
    LDS_WAIT(); asm volatile("" ::: "memory");
    const int n = lane & 31, half = lane >> 5;
    for (int cb = 0; cb < 4; ++cb) {
        float o[8];
#pragma unroll
        for (int i = 0; i < 8; ++i) o[i] = 0.f;
        const float* pwr = pw + (size_t)(g * 64 + half * 32 + cb * 8) * 64;
        for (int e = 0; e < 64; ++e) { const float s = scr[e * 33 + n];
#pragma unroll
            for (int i = 0; i < 8; ++i) o[i] += pwr[i * 64 + e] * s; }
        *(GAS v4u*)(WT + (size_t)(n0 + n) * DM + 768 + g * 64 + half * 32 + cb * 8) = pack8(o);
    }
    LDS_WAIT(); asm volatile("" ::: "memory");
}
__device__ __forceinline__ void p0_prologue(Frame F) {
    launder(F);
    LAS float* scr = (LAS float*)(F.lds + RING_OFF + F.wave * 16384);
    const int gw = F.vcu * NWAVES + F.wave, NGW = F.G * NWAVES;
    constexpr int I_IN = 16 * 72, I_OUTP = 12 * 32, I_OUTF = 4 * 32, I_GU = 16 * 176, I_DN = 44 * 32, I_L = I_IN + I_OUTP + I_OUTF + I_GU + I_DN;
    for (int it = gw; it < 2 * I_L; it += NGW) {
        const int l = it / I_L; int r = it % I_L;
        bf16* wl = (bf16*)(F.ws + WS_W + (size_t)l * W_LAYER);
        if (r < I_IN) { const int kb = r / 72, nb = r % 72; tr_item(F.inp(I_WIN) + (size_t)l * DM * NPROJ, NPROJ, 64 * kb, 32 * nb, F.inp(I_N1) + l * DM, wl + W_IN / 2, DM, 32 * nb, scr, F.lane); continue; } r -= I_IN;
        if (r < I_OUTP) { const int kb = r / 32, nb = r % 32; tr_item(F.inp(I_WOUT) + (size_t)l * DM * DM, DM, 64 * kb, 32 * nb, nullptr, wl + W_OUT / 2, DM, 32 * nb, scr, F.lane); continue; } r -= I_OUTP;
        if (r < I_OUTF) { const int g = r / 32, nb = r % 32; pool_fold_item(F.inp(I_WOUT) + (size_t)l * DM * DM, F.inp(I_PW) + (size_t)l * 4 * 64 * 64, F.inp(I_PS) + l * GW, wl + W_OUT / 2, g, 32 * nb, scr, F.lane); continue; } r -= I_OUTF;
        if (r < I_GU) { const int kb = r / 176, nb = r % 176; const int R = 32 * nb, pn = R >> 8, bj = (R >> 7) & 1, j0 = R & 127;
            tr_item(F.inp(I_WGU) + (size_t)l * DM * NGU, NGU, 64 * kb, bj * FFD + 128 * pn + j0, F.inp(I_N2) + l * DM, wl + W_GU / 2, DM, R, scr, F.lane); continue; } r -= I_GU;
        { const int kb = r / 32, nb = r % 32; tr_item(F.inp(I_WDN) + (size_t)l * FFD * DM, DM, 64 * kb, 32 * nb, nullptr, wl + W_DN / 2, FFD, 32 * nb, scr, F.lane); }
    }
    bf16* xb = (bf16*)(F.ws + WS_XB); float* part1 = (float*)(F.ws + WS_PART1);
    for (int m = gw; m < MPAD; m += NGW) {
        const float* src = m < MP ? F.inp(I_XP) + (size_t)m * DM : (m < MP + MS ? F.inp(I_XS) + (size_t)(m - MP) * DM : nullptr);
        f32x4 v[4]; float s = 0.f;
#pragma unroll
        for (int j = 0; j < 4; ++j) { v[j] = src ? ((const GAS f32x4*)src)[F.lane + 64 * j] : (f32x4){0.f, 0.f, 0.f, 0.f}; s += (v[j].x * v[j].x + v[j].y * v[j].y) + (v[j].z * v[j].z + v[j].w * v[j].w); }
        s = wave_sum(s);
        GAS v2u* o8 = (GAS v2u*)(xb + (size_t)m * DM) + F.lane;
#pragma unroll
        for (int j = 0; j < 4; ++j) { v2u w; w.x = pk2(v[j].x, v[j].y); w.y = pk2(v[j].z, v[j].w); o8[64 * j] = w; }
        if (F.lane < 16) part1[(size_t)m * 16 + F.lane] = F.lane == 0 ? s : 0.f;
    }
    {
        const size_t NT = (size_t)F.G * NWAVES * 64, t0 = (size_t)F.vcu * NWAVES * 64 + F.tid;
        constexpr size_t SEGV = 2047 * 64;
        for (size_t i = t0; i < (size_t)128 * SEGV; i += NT) {
            const int seg = (int)(i / SEGV); const size_t off = i - (size_t)seg * SEGV; const int kv = seg >> 6, lb = seg & 63;
            const f32x4* src = (const f32x4*)(F.inp(kv ? I_CV : I_CK)) + (size_t)lb * 131072 + 64 + off;
            f32x4* dst = (f32x4*)(F.out + (kv ? O_VS : O_KS)) + (size_t)lb * 131072 + off;
            __builtin_nontemporal_store(__builtin_nontemporal_load(src), dst);
        }
    }
}

__device__ __forceinline__ int crow(int r, int hi) { return (r & 3) + 8 * (r >> 2) + 4 * hi; }
__device__ __forceinline__ void attn_prompt_task(const bf16* proj, float* atto, float* lse, int task, LAS unsigned char* vbuf, int lane) {
    const int j = task & 63, t2 = task >> 6, cfg = t2 % 3, bh = t2 / 3, h = bh & 3, b = bh >> 2;
    const int sh = 2 * cfg, nqs = 6 - sh, r = j >> nqs, qt = j & ((1 << nqs) - 1);
    const int c = lane & 31, hh = lane >> 5;
    const size_t rowb = (size_t)b * SEQ;
    const float sc2 = 0.125f * 1.4426950408889634f;
    bf16x8 qf[4];
    { const bf16* qp = proj + (rowb + (((32 * qt + c) << sh) + r)) * NPROJ + C_Q + h * 64 + 8 * hh;
#pragma unroll
      for (int s = 0; s < 4; ++s) qf[s] = *(const GAS bf16x8*)(qp + 16 * s); }
    f32x16 O0, O1;
#pragma unroll
    for (int i = 0; i < 16; ++i) { O0[i] = 0.f; O1[i] = 0.f; }
    float mrun = -1e30f, lsum = 0.f;
    const int kt_lo = qt > 4 ? qt - 4 : 0;
    const int trb = (4 * hh + ((lane & 15) >> 2)) * 64 + (16 * ((lane >> 4) & 1) + 4 * (lane & 3)) * 2;
    bf16x8 kfn[4]; v4u vvn[4];
    { const int kt = kt_lo;
      const bf16* kp = proj + (rowb + (((32 * kt + c) << sh) + r)) * NPROJ + C_K + h * 64 + 8 * hh;
#pragma unroll
      for (int s = 0; s < 4; ++s) kfn[s] = *(const GAS bf16x8*)(kp + 16 * s);
#pragma unroll
      for (int i = 0; i < 4; ++i) { const int id = lane + 64 * i, key = id >> 3, ch = id & 7;
          vvn[i] = *(const GAS v4u*)(proj + (rowb + (((32 * kt + key) << sh) + r)) * NPROJ + C_V + h * 64 + ch * 8); } }
    for (int kt = kt_lo; kt <= qt; ++kt) {
        bf16x8 kf[4]; v4u vv[4];
#pragma unroll
        for (int s = 0; s < 4; ++s) { kf[s] = kfn[s]; vv[s] = vvn[s]; }
        if (kt < qt) {
            const bf16* kp = proj + (rowb + (((32 * (kt + 1) + c) << sh) + r)) * NPROJ + C_K + h * 64 + 8 * hh;
#pragma unroll
            for (int s = 0; s < 4; ++s) kfn[s] = *(const GAS bf16x8*)(kp + 16 * s);
#pragma unroll
            for (int i = 0; i < 4; ++i) { const int id = lane + 64 * i, key = id >> 3, ch = id & 7;
                vvn[i] = *(const GAS v4u*)(proj + (rowb + (((32 * (kt + 1) + key) << sh) + r)) * NPROJ + C_V + h * 64 + ch * 8); }
        }
        f32x16 S;
#pragma unroll
        for (int i = 0; i < 16; ++i) S[i] = 0.f;
#pragma unroll
        for (int s = 0; s < 4; ++s) S = __builtin_amdgcn_mfma_f32_32x32x16_bf16(kf[s], qf[s], S, 0, 0, 0);
        float x[16];
        if (kt == qt || kt == qt - 4) {
            const int relb = 32 * (qt - kt) + c;
#pragma unroll
            for (int i = 0; i < 16; ++i) { const int rel = relb - crow(i, hh); x[i] = (rel >= 0 && rel <= 128) ? S[i] * sc2 : -1e30f; }
        } else {
#pragma unroll
            for (int i = 0; i < 16; ++i) x[i] = S[i] * sc2;
        }
        float mx = x[0];
#pragma unroll
        for (int i = 1; i < 16; ++i) mx = fmaxf(mx, x[i]);
        mx = fmaxf(mx, __shfl_xor(mx, 32));
        const float mnew = fmaxf(mrun, mx), alpha = __builtin_amdgcn_exp2f(mrun - mnew);
        mrun = mnew;
        float ps = 0.f;
#pragma unroll
        for (int i = 0; i < 16; ++i) { x[i] = __builtin_amdgcn_exp2f(x[i] - mnew); ps += x[i]; }
        lsum = lsum * alpha + ps;
#pragma unroll
        for (int i = 0; i < 16; ++i) { O0[i] *= alpha; O1[i] *= alpha; }
        bf16x8 pb[2];
#pragma unroll
        for (int s = 0; s < 2; ++s) { v4u w; w.x = pk2(x[8 * s + 0], x[8 * s + 1]); w.y = pk2(x[8 * s + 2], x[8 * s + 3]); w.z = pk2(x[8 * s + 4], x[8 * s + 5]); w.w = pk2(x[8 * s + 6], x[8 * s + 7]); pb[s] = __builtin_bit_cast(bf16x8, w); }
#pragma unroll
        for (int i = 0; i < 4; ++i) { const int id = lane + 64 * i, key = id >> 3, ch = id & 7;
            *(LAS v4u*)(vbuf + (ch >> 2) * 2048 + key * 64 + (ch & 3) * 16) = vv[i]; }
        asm volatile("s_waitcnt lgkmcnt(0)" ::: "memory");
#pragma unroll
        for (int s = 0; s < 2; ++s) {
            const s16x4 a00 = __builtin_bit_cast(s16x4, __builtin_amdgcn_ds_read_tr16_b64_v4i16((LAS s16x4*)(vbuf + trb + (16 * s) * 64)));
            const s16x4 a01 = __builtin_bit_cast(s16x4, __builtin_amdgcn_ds_read_tr16_b64_v4i16((LAS s16x4*)(vbuf + trb + (16 * s + 8) * 64)));
            const s16x4 a10 = __builtin_bit_cast(s16x4, __builtin_amdgcn_ds_read_tr16_b64_v4i16((LAS s16x4*)(vbuf + 2048 + trb + (16 * s) * 64)));
            const s16x4 a11 = __builtin_bit_cast(s16x4, __builtin_amdgcn_ds_read_tr16_b64_v4i16((LAS s16x4*)(vbuf + 2048 + trb + (16 * s + 8) * 64)));
            const bf16x8 A0 = __builtin_shufflevector(a00, a01, 0, 1, 2, 3, 4, 5, 6, 7), A1 = __builtin_shufflevector(a10, a11, 0, 1, 2, 3, 4, 5, 6, 7);
            O0 = __builtin_amdgcn_mfma_f32_32x32x16_bf16(A0, pb[s], O0, 0, 0, 0);
            O1 = __builtin_amdgcn_mfma_f32_32x32x16_bf16(A1, pb[s], O1, 0, 0, 0);
        }
        asm volatile("s_waitcnt lgkmcnt(0)" ::: "memory");
    }
    const float ltot = lsum + __shfl_xor(lsum, 32), inv = 1.0f / ltot;
    const size_t qrow = rowb + (((32 * qt + c) << sh) + r);
    float* op = atto + ((size_t)cfg * MPAD + qrow) * 256 + h * 64 + 4 * hh;
#pragma unroll
    for (int g = 0; g < 4; ++g) {
        *(GAS f32x4*)(op + 8 * g) = (f32x4){O0[4 * g] * inv, O0[4 * g + 1] * inv, O0[4 * g + 2] * inv, O0[4 * g + 3] * inv};
        *(GAS f32x4*)(op + 32 + 8 * g) = (f32x4){O1[4 * g] * inv, O1[4 * g + 1] * inv, O1[4 * g + 2] * inv, O1[4 * g + 3] * inv};
    }
    if (hh == 0) lse[((size_t)cfg * MPAD + qrow) * 4 + h] = mrun * 0.6931471805599453f + __logf(ltot);
}
__device__ __forceinline__ void attn_sample_task(const Frame& F, int l, int s, LAS float* pbuf) {
    const int h = s & 3, b = (s >> 2) & 31, cfg = s >> 7, dil = 1 << (2 * cfg), lane = F.lane;
    const bf16* proj = (const bf16*)(F.ws + WS_PROJ);
    const bf16* prow = proj + (size_t)(MP + b) * NPROJ;
    const float* ck = F.inp(I_CK) + ((size_t)(l * 32 + b) * BUF) * 256 + h * 64;
    const float* cv = F.inp(I_CV) + ((size_t)(l * 32 + b) * BUF) * 256 + h * 64;
    float q[64];
#pragma unroll
    for (int i = 0; i < 8; ++i) unpack8(*(const GAS v4u*)(prow + C_Q + h * 64 + 8 * i), q + 8 * i);
    float sc[3];
#pragma unroll
    for (int it = 0; it < 3; ++it) {
        const int i = lane + 64 * it; float d = 0.f;
        if (i <= 128) {
            if (i == 0) {
#pragma unroll
                for (int u = 0; u < 8; ++u) { float kk[8]; unpack8(*(const GAS v4u*)(prow + C_K + h * 64 + 8 * u), kk);
#pragma unroll
                    for (int e = 0; e < 8; ++e) d += q[8 * u + e] * kk[e]; }
            } else {
                const GAS f32x4* kr = (const GAS f32x4*)(ck + (size_t)(BUF - i * dil) * 256);
#pragma unroll
                for (int u = 0; u < 16; ++u) { const f32x4 kk = kr[u]; d += (q[4 * u] * kk.x + q[4 * u + 1] * kk.y) + (q[4 * u + 2] * kk.z + q[4 * u + 3] * kk.w); }
            }
            sc[it] = d * 0.125f;
        } else sc[it] = -1e30f;
    }
    const float m = wave_max(fmaxf(fmaxf(sc[0], sc[1]), sc[2]));
    float den = 0.f;
#pragma unroll
    for (int it = 0; it < 3; ++it) { const int i = lane + 64 * it; const float p = (i <= 128) ? __expf(sc[it] - m) : 0.f; den += p; if (i <= 128) pbuf[i] = p; }
    den = wave_sum(den);
    asm volatile("s_waitcnt lgkmcnt(0)" ::: "memory");
    float o = pbuf[0] * bflo((unsigned)prow[C_V + h * 64 + lane]);
    for (int i = 1; i <= 128; ++i) o += pbuf[i] * cv[(size_t)(BUF - i * dil) * 256 + lane];
    asm volatile("s_waitcnt lgkmcnt(0)" ::: "memory");
    float* atto = (float*)(F.ws + WS_ATTO); float* lse = (float*)(F.ws + WS_LSE);
    atto[((size_t)cfg * MPAD + MP + b) * 256 + h * 64 + lane] = o / den;
    if (lane == 0) lse[((size_t)cfg * MPAD + MP + b) * 4 + h] = m + __logf(den);
}
__device__ __forceinline__ void attn_phase(Frame F, int l) {
    launder(F); asm volatile("" : "+s"(l));
    const bf16* proj = (const bf16*)(F.ws + WS_PROJ); float* atto = (float*)(F.ws + WS_ATTO); float* lse = (float*)(F.ws + WS_LSE);
    const int gw = F.vcu * NWAVES + F.wave, NGW = F.G * NWAVES;
    LAS unsigned char* vbuf = F.lds + RING_OFF + F.wave * 8192;
    for (int t = gw; t < NB * 4 * 3 * 64; t += NGW) attn_prompt_task(proj, atto, lse, t, vbuf, F.lane);
    for (int s = gw; s < 3 * 32 * 4; s += NGW) attn_sample_task(F, l, s, (LAS float*)(vbuf + 4096));
}

__device__ __forceinline__ void mixer_prompt_tile(Frame& F, int l, int tile) {
    const bf16* proj = (const bf16*)(F.ws + WS_PROJ); bf16* mix = (bf16*)(F.ws + WS_MIX);
    const float* atto = (const float*)(F.ws + WS_ATTO); const float* lse = (const float*)(F.ws + WS_LSE);
    const int b = tile >> 6, t0 = (tile & 63) * 32, tid = F.tid, lane = F.lane;
    const size_t rowb = (size_t)b * SEQ;
    LAS float* ga = (LAS float*)(F.lds + RING_OFF);
    LAS float* yp = ga + 62 * 256;
    for (int it = tid; it < 62 * 32; it += NWAVES * 64) {
        const int rr = it >> 5, ch = it & 31, t = t0 - 30 + rr;
        float g8[8];
        if (t >= 0) { float a8[8], s8[8]; const bf16* pr = proj + (rowb + t) * NPROJ + ch * 8;
            unpack8(*(const GAS v4u*)(pr + C_AV), a8); unpack8(*(const GAS v4u*)(pr + C_AG), s8);
#pragma unroll
            for (int e = 0; e < 8; ++e) g8[e] = a8[e] * sigmoidf_(s8[e]);
        } else {
#pragma unroll
            for (int e = 0; e < 8; ++e) g8[e] = 0.f; }
        *(LAS f32x4*)(ga + rr * 256 + ch * 8) = (f32x4){g8[0], g8[1], g8[2], g8[3]}; *(LAS f32x4*)(ga + rr * 256 + ch * 8 + 4) = (f32x4){g8[4], g8[5], g8[6], g8[7]};
        if (t0 == SEQ - 32 && rr >= 32) { float* d = F.out + O_AP + ((size_t)(l * NB + b) * 30 + (rr - 32)) * 256 + ch * 8;
            *(GAS f32x4*)d = (f32x4){g8[0], g8[1], g8[2], g8[3]}; *(GAS f32x4*)(d + 4) = (f32x4){g8[4], g8[5], g8[6], g8[7]}; }
    }
    __syncthreads();
    {
        const int c = tid & 255, half = tid >> 8;
        const float* cw = F.inp(I_CAW) + (size_t)l * 31 * 256 + c;
        float w[31];
#pragma unroll
        for (int jj = 0; jj < 31; ++jj) w[jj] = cw[jj * 256];
        const float bias = F.inp(I_CAB)[l * 256 + c];
        float acc[16];
#pragma unroll
        for (int t = 0; t < 16; ++t) acc[t] = bias;
#pragma unroll
        for (int rr = 0; rr < 46; ++rr) { const float v = ga[(half * 16 + rr) * 256 + c];
#pragma unroll
            for (int t = 0; t < 16; ++t) { const int jj = rr - t; if (jj >= 0 && jj <= 30) acc[t] += w[jj] * v; } }
#pragma unroll
        for (int t = 0; t < 16; ++t) yp[(half * 16 + t) * 256 + c] = acc[t];
    }
    __syncthreads();
    {
        const f32x4 g4 = *(const GAS f32x4*)(F.inp(I_LNG) + l * 256 + 4 * lane), b4 = *(const GAS f32x4*)(F.inp(I_LNB) + l * 256 + 4 * lane);
#pragma unroll
        for (int tt = 0; tt < 4; ++tt) { const int tok = F.wave * 4 + tt;
            const f32x4 xv = *(LAS f32x4*)(yp + tok * 256 + 4 * lane);
            const float mean = wave_sum((xv.x + xv.y) + (xv.z + xv.w)) * (1.f / 256.f);
            const f32x4 d = xv - mean;
            const float var = wave_sum((d.x * d.x + d.y * d.y) + (d.z * d.z + d.w * d.w)) * (1.f / 256.f);
            const float rstd = __builtin_amdgcn_rsqf(var + EPSN);
            f32x4 y = d * rstd * g4 + b4;
            y.x *= sigmoidf_(y.x); y.y *= sigmoidf_(y.y); y.z *= sigmoidf_(y.z); y.w *= sigmoidf_(y.w);
            v2u w; w.x = pk2(y.x, y.y); w.y = pk2(y.z, y.w);
            *(GAS v2u*)(mix + (rowb + t0 + tok) * DM + 4 * lane) = w; }
    }
    for (int it = tid; it < 32 * 32; it += NWAVES * 64) {
        const int tok = it >> 5, ch = it & 31, t = t0 + tok; const size_t row = rowb + t;
        const bf16* pr = proj + row * NPROJ + ch * 8;
        {
            float cb8[8], cx[3][8];
            unpack8(*(const GAS v4u*)(pr + C_CB), cb8);
#pragma unroll
            for (int k = 0; k < 3; ++k) {
                if (t - k >= 0) { float a8[8], c8[8]; unpack8(*(const GAS v4u*)(pr - (size_t)k * NPROJ + C_CX), a8); unpack8(*(const GAS v4u*)(pr - (size_t)k * NPROJ + C_CC), c8);
#pragma unroll
                    for (int e = 0; e < 8; ++e) cx[k][e] = a8[e] * c8[e];
                } else {
#pragma unroll
                    for (int e = 0; e < 8; ++e) cx[k][e] = 0.f; } }
            const float* cw = F.inp(I_CCW) + (size_t)l * 3 * 256 + ch * 8;
            float o[8];
#pragma unroll
            for (int e = 0; e < 8; ++e) o[e] = cb8[e] * (cw[e] * cx[2][e] + cw[256 + e] * cx[1][e] + cw[512 + e] * cx[0][e]);
            *(GAS v4u*)(mix + row * DM + 512 + ch * 8) = pack8(o);
            if (t >= SEQ - 2) { float* d = F.out + O_CP + ((size_t)(l * NB + b) * 2 + (t - (SEQ - 2))) * 256 + ch * 8;
                *(GAS f32x4*)d = (f32x4){cx[0][0], cx[0][1], cx[0][2], cx[0][3]}; *(GAS f32x4*)(d + 4) = (f32x4){cx[0][4], cx[0][5], cx[0][6], cx[0][7]}; }
        }
        {
            const int w = 2 << (ch >> 3);
            float u0[8], s8[8];
            unpack8(*(const GAS v4u*)(pr + C_DU), u0);
#pragma unroll
            for (int e = 0; e < 8; ++e) s8[e] = u0[e];
            for (int k = 1; k < w; ++k) if (t - k >= 0) { float uk[8]; unpack8(*(const GAS v4u*)(pr - (size_t)k * NPROJ + C_DU), uk);
#pragma unroll
                for (int e = 0; e < 8; ++e) s8[e] += uk[e]; }
            const float cnt = (float)(w < t + 1 ? w : t + 1), ic = 1.0f / cnt;
            float o[8];
#pragma unroll
            for (int e = 0; e < 8; ++e) o[e] = s8[e] * ic - u0[e];
            *(GAS v4u*)(mix + row * DM + 768 + ch * 8) = pack8(o);
            if (t >= SEQ - 15) { float* d = F.out + O_PP + ((size_t)(l * NB + b) * 15 + (t - (SEQ - 15))) * 256 + ch * 8;
                *(GAS f32x4*)d = (f32x4){u0[0], u0[1], u0[2], u0[3]}; *(GAS f32x4*)(d + 4) = (f32x4){u0[4], u0[5], u0[6], u0[7]}; }
        }
        {
            const int h = ch >> 3;
            const float l0 = lse[((size_t)0 * MPAD + row) * 4 + h], l1 = lse[((size_t)1 * MPAD + row) * 4 + h], l2 = lse[((size_t)2 * MPAD + row) * 4 + h];
            const float mx = fmaxf(fmaxf(l0, l1), l2);
            float e0 = __expf(l0 - mx), e1 = __expf(l1 - mx), e2 = __expf(l2 - mx); const float inv = 1.0f / (e0 + e1 + e2);
            e0 *= inv; e1 *= inv; e2 *= inv;
            const float* a0 = atto + ((size_t)0 * MPAD + row) * 256 + ch * 8; const float* a1 = a0 + (size_t)MPAD * 256; const float* a2 = a1 + (size_t)MPAD * 256;
            float o[8];
#pragma unroll
            for (int q4 = 0; q4 < 2; ++q4) { const f32x4 x0 = *(const GAS f32x4*)(a0 + 4 * q4), x1 = *(const GAS f32x4*)(a1 + 4 * q4), x2 = *(const GAS f32x4*)(a2 + 4 * q4);
                const f32x4 y = x0 * e0 + x1 * e1 + x2 * e2; o[4 * q4] = y.x; o[4 * q4 + 1] = y.y; o[4 * q4 + 2] = y.z; o[4 * q4 + 3] = y.w; }
            *(GAS v4u*)(mix + row * DM + 256 + ch * 8) = pack8(o);
        }
    }
    __syncthreads();
}
__device__ __forceinline__ void mixer_sample_row(Frame& F, int l, int b) {
    const bf16* proj = (const bf16*)(F.ws + WS_PROJ); bf16* mix = (bf16*)(F.ws + WS_MIX);
    const float* atto = (const float*)(F.ws + WS_ATTO); const float* lse = (const float*)(F.ws + WS_LSE);
    const int lane = F.lane, c4 = 4 * lane; const size_t row = MP + b;
    const bf16* pr = proj + row * NPROJ + c4;
    auto ld4 = [&](int col, float* f) { const v2u w = *(const GAS v2u*)(pr + col); f[0] = bflo(w.x); f[1] = bfhi(w.x); f[2] = bflo(w.y); f[3] = bfhi(w.y); };
    auto st4 = [&](int col, const float* f) { v2u w; w.x = pk2(f[0], f[1]); w.y = pk2(f[2], f[3]); *(GAS v2u*)(mix + row * DM + col + c4) = w; };
    {
        float a[4], g[4], gn[4]; ld4(C_AV, a); ld4(C_AG, g);
#pragma unroll
        for (int e = 0; e < 4; ++e) gn[e] = a[e] * sigmoidf_(g[e]);
        const float* st = F.inp(I_SA) + ((size_t)(l * 32 + b) * 30) * 256 + c4;
        const float* cw = F.inp(I_CAW) + (size_t)l * 31 * 256 + c4;
        float* so = F.out + O_AS + ((size_t)(l * 32 + b) * 30) * 256 + c4;
        f32x4 acc = *(const GAS f32x4*)(F.inp(I_CAB) + l * 256 + c4);
        for (int jj = 0; jj < 30; ++jj) { const f32x4 sv = *(const GAS f32x4*)(st + jj * 256), wv = *(const GAS f32x4*)(cw + jj * 256); acc += sv * wv; if (jj >= 1) *(GAS f32x4*)(so + (jj - 1) * 256) = sv; }
        const f32x4 wl = *(const GAS f32x4*)(cw + 30 * 256), gv = (f32x4){gn[0], gn[1], gn[2], gn[3]};
        acc += wl * gv; *(GAS f32x4*)(so + 29 * 256) = gv;
        const float mean = wave_sum((acc.x + acc.y) + (acc.z + acc.w)) * (1.f / 256.f);
        const f32x4 d = acc - mean;
        const float var = wave_sum((d.x * d.x + d.y * d.y) + (d.z * d.z + d.w * d.w)) * (1.f / 256.f);
        const float rstd = __builtin_amdgcn_rsqf(var + EPSN);
        const f32x4 g4 = *(const GAS f32x4*)(F.inp(I_LNG) + l * 256 + c4), b4 = *(const GAS f32x4*)(F.inp(I_LNB) + l * 256 + c4);
        f32x4 y = d * rstd * g4 + b4;
        float o[4] = {y.x * sigmoidf_(y.x), y.y * sigmoidf_(y.y), y.z * sigmoidf_(y.z), y.w * sigmoidf_(y.w)};
        st4(0, o);
    }
    {
        float x[4], cb[4], cc[4]; ld4(C_CX, x); ld4(C_CB, cb); ld4(C_CC, cc);
        const float* st = F.inp(I_SC) + ((size_t)(l * 32 + b) * 2) * 256 + c4;
        const float* cw = F.inp(I_CCW) + (size_t)l * 3 * 256 + c4;
        float* so = F.out + O_CS + ((size_t)(l * 32 + b) * 2) * 256 + c4;
        const f32x4 s0 = *(const GAS f32x4*)st, s1 = *(const GAS f32x4*)(st + 256), w0 = *(const GAS f32x4*)cw, w1 = *(const GAS f32x4*)(cw + 256), w2 = *(const GAS f32x4*)(cw + 512);
        const f32x4 cxn = (f32x4){x[0] * cc[0], x[1] * cc[1], x[2] * cc[2], x[3] * cc[3]};
        const f32x4 y = (f32x4){cb[0], cb[1], cb[2], cb[3]} * (w0 * s0 + w1 * s1 + w2 * cxn);
        *(GAS f32x4*)so = s1; *(GAS f32x4*)(so + 256) = cxn;
        float o[4] = {y.x, y.y, y.z, y.w}; st4(512, o);
    }
    {
        float u[4]; ld4(C_DU, u);
        const float* st = F.inp(I_SP) + ((size_t)(l * 32 + b) * 15) * 256 + c4;
        float* so = F.out + O_PS + ((size_t)(l * 32 + b) * 15) * 256 + c4;
        const int w = 2 << (lane >> 4);
        f32x4 s = (f32x4){u[0], u[1], u[2], u[3]};
        for (int jj = 0; jj < 15; ++jj) { const f32x4 sv = *(const GAS f32x4*)(st + jj * 256); if (15 - jj < w) s += sv; if (jj >= 1) *(GAS f32x4*)(so + (jj - 1) * 256) = sv; }
        *(GAS f32x4*)(so + 14 * 256) = (f32x4){u[0], u[1], u[2], u[3]};
        const float iw = 1.0f / (float)w;
        float o[4] = {s.x * iw - u[0], s.y * iw - u[1], s.z * iw - u[2], s.w * iw - u[3]}; st4(768, o);
    }
    {
        const int h = lane >> 4;
        const float l0 = lse[((size_t)0 * MPAD + row) * 4 + h], l1 = lse[((size_t)1 * MPAD + row) * 4 + h], l2 = lse[((size_t)2 * MPAD + row) * 4 + h];
        const float mx = fmaxf(fmaxf(l0, l1), l2);
        float e0 = __expf(l0 - mx), e1 = __expf(l1 - mx), e2 = __expf(l2 - mx); const float inv = 1.0f / (e0 + e1 + e2);
        e0 *= inv; e1 *= inv; e2 *= inv;
        const float* a0 = atto + ((size_t)0 * MPAD + row) * 256 + c4;
        const f32x4 y = *(const GAS f32x4*)a0 * e0 + *(const GAS f32x4*)(a0 + (size_t)MPAD * 256) * e1 + *(const GAS f32x4*)(a0 + (size_t)2 * MPAD * 256) * e2;
        float o[4] = {y.x, y.y, y.z, y.w}; st4(256, o);
    }
}
__device__ __forceinline__ void mixer_phase(Frame F, int l) {
    launder(F); asm volatile("" : "+s"(l));
    for (int tile = F.vcu; tile < NB * 64; tile += F.G) mixer_prompt_tile(F, l, tile);
    const int gw = F.vcu * NWAVES + F.wave, NGW = F.G * NWAVES;
    for (int b = gw; b < MS; b += NGW) mixer_sample_row(F, l, b);
}
__device__ __forceinline__ void final_phase(Frame F) {
    launder(F);
    const float* X = (const float*)(F.ws + WS_X); const float* part = (const float*)(F.ws + WS_PART1);
    const int gw = F.vcu * NWAVES + F.wave, NGW = F.G * NWAVES;
    for (int m = gw; m < MP + MS; m += NGW) {
        const float pv = F.lane < 16 ? part[(size_t)m * 16 + F.lane] : 0.f;
        const float rs = __builtin_amdgcn_rsqf(wave_sum(pv) * (1.0f / 1024.0f) + EPSN);
        float* o = m < MP ? F.out + O_Y + (size_t)m * DM : F.out + O_YS + (size_t)(m - MP) * DM;
#pragma unroll
        for (int j = 0; j < 4; ++j) { const f32x4 v = ((const GAS f32x4*)(X + (size_t)m * DM))[F.lane + 64 * j], g = ((const GAS f32x4*)F.inp(I_FG))[F.lane + 64 * j];
            ((GAS f32x4*)o)[F.lane + 64 * j] = v * rs * g; }
    }
}

__device__ __forceinline__ void phase_inproj(Frame F, int l) {
    launder(F); asm volatile("" : "+s"(l));
    const bf16* wl = (const bf16*)(F.ws + WS_W + (size_t)l * W_LAYER);
    pg8::Gemm g{(const bf16*)(F.ws + WS_XB), wl + W_IN / 2, MPAD, NPROJ, DM}; pg8::StaticOrder S; S.init(MPAD, NPROJ, F.G, (int)blockIdx.x);
    pg8::EpiProj E{(bf16*)(F.ws + WS_PROJ), (const float*)(F.ws + WS_PART1), F.out + O_KP + (size_t)l * MP * 256, F.out + O_VP + (size_t)l * MP * 256,
                   F.out + O_KS + (size_t)l * 32 * BUF * 256, F.out + O_VS + (size_t)l * 32 * BUF * 256, MP, NPROJ};
    pg8::gemm_phase<pg8::EpiProj, pg8::StaticOrder, true, true>(F.lds + RING_OFF, g, S, E, F.tid);
}
__device__ __forceinline__ void phase_outproj(Frame F, int l) {
    launder(F); asm volatile("" : "+s"(l));
    const bf16* wl = (const bf16*)(F.ws + WS_W + (size_t)l * W_LAYER); float* X = (float*)(F.ws + WS_X);
    pg8::Gemm g{(const bf16*)(F.ws + WS_MIX), wl + W_OUT / 2, MPAD, DM, DM}; pg8::StaticOrder S; S.init(MPAD, DM, F.G, (int)blockIdx.x);
    pg8::EpiRes E{l == 0 ? F.inp(I_XP) : X, l == 0 ? F.inp(I_XS) : X + (size_t)MP * DM, X, (bf16*)(F.ws + WS_X1B), (float*)(F.ws + WS_PART2), MP};
    pg8::gemm_phase<pg8::EpiRes, pg8::StaticOrder, true, true>(F.lds + RING_OFF, g, S, E, F.tid);
}
__device__ __forceinline__ void phase_gateup(Frame F, int l) {
    launder(F); asm volatile("" : "+s"(l));
    const bf16* wl = (const bf16*)(F.ws + WS_W + (size_t)l * W_LAYER);
    pg8::Gemm g{(const bf16*)(F.ws + WS_X1B), wl + W_GU / 2, MPAD, NGU, DM}; pg8::StaticOrder S; S.init(MPAD, NGU, F.G, (int)blockIdx.x);
    pg8::EpiSwiGLU E{(bf16*)(F.ws + WS_ACT), (const float*)(F.ws + WS_PART2), FFD};
    pg8::gemm_phase<pg8::EpiSwiGLU, pg8::StaticOrder, true, true>(F.lds + RING_OFF, g, S, E, F.tid);
}
__device__ __forceinline__ void phase_down(Frame F, int l) {
    launder(F); asm volatile("" : "+s"(l));
    const bf16* wl = (const bf16*)(F.ws + WS_W + (size_t)l * W_LAYER); float* X = (float*)(F.ws + WS_X);
    pg8::Gemm g{(const bf16*)(F.ws + WS_ACT), wl + W_DN / 2, MPAD, DM, FFD}; pg8::StaticOrder S; S.init(MPAD, DM, F.G, (int)blockIdx.x);
    pg8::EpiRes E{X, X + (size_t)MP * DM, X, (bf16*)(F.ws + WS_XB), (float*)(F.ws + WS_PART1), MP};
    pg8::gemm_phase<pg8::EpiRes, pg8::StaticOrder, true, true>(F.lds + RING_OFF, g, S, E, F.tid);
}

__global__ void __launch_bounds__(NWAVES * 64, 2) fwd_megakernel(Args args) {
    extern __shared__ __attribute__((aligned(16))) unsigned char lds[];
    Frame F;
    F.lds = (LAS unsigned char*)lds;
    F.tid = threadIdx.x; F.lane = F.tid & 63; F.wave = __builtin_amdgcn_readfirstlane(F.tid >> 6);
    F.G = gridDim.x; { const int bx = blockIdx.x; F.vcu = (F.G % 8 == 0) ? (bx % 8) * (F.G / 8) + bx / 8 : bx; }
    F.ka = (kaptr_t)__builtin_amdgcn_kernarg_segment_ptr();
    F.out = args.out; F.ws = args.ws;
    for (int u = F.tid; u < (LDS_BYTES - LDSCTL_OFF) / 4; u += NWAVES * 64) ((LAS unsigned*)(F.lds + LDSCTL_OFF))[u] = 0u;
    __syncthreads();
    XcdBarrier bar = xcd_barrier_post((unsigned*)(F.ws + WS_CTL) + CW_BAR, (volatile LAS unsigned*)(F.lds + MISC_OFF) + 8);
#define GRID_BAR() xcd_barrier(bar)

#if !defined(PH) || (PH & 1)
    p0_prologue(F);
#endif
    GRID_BAR();
#pragma unroll 1
    for (int l = 0; l < DEPTH; ++l) {
#if !defined(PH) || (PH & 2)
        phase_inproj(F, l);
#endif
        GRID_BAR();
#if !defined(PH) || (PH & 4)
        attn_phase(F, l);
#endif
        GRID_BAR();
#if !defined(PH) || (PH & 8)
        mixer_phase(F, l);
#endif
        GRID_BAR();
#if !defined(PH) || (PH & 16)
        phase_outproj(F, l);
#endif
        GRID_BAR();
#if !defined(PH) || (PH & 32)
        phase_gateup(F, l);
#endif
        GRID_BAR();
#if !defined(PH) || (PH & 64)
        phase_down(F, l);
#endif
        GRID_BAR();
    }
#if !defined(PH) || (PH & 128)
    final_phase(F);
#endif
}

extern "C" void kernel_launch(void* const* d_in, const int* in_sizes, int n_in, void* d_out, int out_size, void* d_ws, size_t ws_size, hipStream_t stream) {
    static int grid = 0;
    if (grid == 0) {
        if (n_in != 21 || (size_t)out_size != O_END || ws_size < WS_END) { fprintf(stderr, "kernel_launch: unexpected shapes: n_in %d out %d ws %zu\n", n_in, out_size, ws_size); grid = -1; return; }
        int dev = 0, cus = 0, per_cu = 0;
        if (hipGetDevice(&dev) != hipSuccess || hipDeviceGetAttribute(&cus, hipDeviceAttributeMultiprocessorCount, dev) != hipSuccess) { fprintf(stderr, "kernel_launch: device query failed\n"); grid = -1; return; }
        if (hipFuncSetAttribute((const void*)fwd_megakernel, hipFuncAttributeMaxDynamicSharedMemorySize, LDS_BYTES) != hipSuccess) { fprintf(stderr, "kernel_launch: hipFuncSetAttribute failed\n"); grid = -1; return; }
        if (hipOccupancyMaxActiveBlocksPerMultiprocessor(&per_cu, (const void*)fwd_megakernel, NWAVES * 64, LDS_BYTES) != hipSuccess || per_cu < 1) { fprintf(stderr, "kernel_launch: occupancy query says %d blocks per CU\n", per_cu); grid = -1; (void)hipGetLastError(); return; }
        grid = cus;
    }
    if (grid < 0) return;
    if (hipMemsetAsync((char*)d_ws + WS_CTL, 0, CTL_ZERO_BYTES, stream) != hipSuccess) { fprintf(stderr, "kernel_launch: memset failed\n"); return; }
    Args a{};
    for (int i = 0; i < 21; ++i) a.in[i] = (const float*)d_in[i];
    a.out = (float*)d_out; a.ws = (unsigned char*)d_ws;
    void* kargs[] = {&a};
    hipError_t e = hipLaunchCooperativeKernel((const void*)fwd_megakernel, dim3(grid), dim3(NWAVES * 64), kargs, LDS_BYTES, stream);
    if (e != hipSuccess) fprintf(stderr, "kernel_launch: cooperative launch failed: %s (grid %d)\n", hipGetErrorString(e), grid);
}
```

```cpp
#include <hip/hip_runtime.h>
#include <cstdio>
#include <cstdint>

constexpr int DM = 1024, NPROJ = 2304, FFD = 2816, NGU = 5632, GW = 256;
constexpr int NB = 8, SEQ = 2048, MP = NB * SEQ, MS = 32, MPAD = 16640, DEPTH = 2, BUF = 2048;
constexpr float EPSN = 1e-6f;
constexpr int C_AV = 0, C_AG = 256, C_Q = 512, C_K = 768, C_V = 1024, C_CX = 1280, C_CB = 1536, C_CC = 1792, C_DU = 2048;
constexpr size_t O_Y = 0, O_YS = 16777216, O_KP = 16809984, O_VP = 25198592, O_AP = 33587200, O_CP = 33710080, O_PP = 33718272,
                 O_KS = 33779712, O_VS = 67334144, O_AS = 100888576, O_CS = 101380096, O_PS = 101412864, O_END = 101658624;
namespace pg8 {
#define PG8_LAS __attribute__((address_space(3)))
typedef unsigned short bf16_t;
typedef short bf16x8 __attribute__((ext_vector_type(8)));
typedef float f32x4 __attribute__((ext_vector_type(4)));
typedef unsigned u32x4 __attribute__((ext_vector_type(4)));
constexpr int BM = 256, BK = 64, HALF = 128, HTB = HALF * BK * 2  , STAGE_BYTES = 8 * HTB, NXCD = 8, WGM = 8;

__host__ __device__ __forceinline__ int lds_byte(int r, int c) { const int st = (r >> 4) * 2 + (c >> 5), rr = r & 15, cc = c & 31, ob = rr * 64 + cc * 2; return st * 1024 + (ob ^ (((ob >> 9) & 1) << 5)); }
__host__ __device__ __forceinline__ void stage_rc(int b, int& R, int& C) { const int st = b / 1024, sb = b % 1024, swz = sb ^ (((sb >> 9) & 1) << 5); R = (st >> 1) * 16 + swz / 64; C = (st & 1) * 32 + (swz % 64) / 2; }
__host__ __device__ __forceinline__ int perm32(int rho) { const int n = rho >> 4, i = rho & 15; return 8 * (i >> 2) + 4 * n + (i & 3); }

struct Unit { int pm, pn; };
struct Gemm { const bf16_t* A; const bf16_t* Bt; int M, N, K; };

struct StaticOrder {
    int nM, nN, nwg, G, c;
    __host__ __device__ void init(int M, int N, int G_, int c_) { nM = M / BM; nN = N / BM; nwg = nM * nN; G = G_; c = c_; }
    __host__ __device__ bool next(int i, Unit& u) const {
        const long L = (long)i * G + c; if (L >= nwg) return false;
        int wgid = (int)L; { const int q = nwg / NXCD, r = nwg % NXCD, xcd = wgid % NXCD, off = wgid / NXCD; wgid = (xcd < r ? xcd * (q + 1) : r * (q + 1) + (xcd - r) * q) + off; }
        const int nig = WGM * nN, gid = wgid / nig, fm = gid * WGM, gsz = (nM - fm) < WGM ? (nM - fm) : WGM;
        u.pm = fm + ((wgid % nig) % gsz); u.pn = (wgid % nig) / gsz; return true;
    }
    __device__ __forceinline__ void a_ready(const Unit&) const {}
    __device__ __forceinline__ void done(const Unit&) const {}
};
__device__ __forceinline__ unsigned cvt_pk_bf16(float lo, float hi) { unsigned r; asm volatile("v_cvt_pk_bf16_f32 %0, %1, %2" : "=v"(r) : "v"(lo), "v"(hi)); return r; }
typedef float f32x2 __attribute__((ext_vector_type(2)));
__device__ __forceinline__ float row_rs(const float* part, int row, int fq) {
    const f32x4 p = *(const f32x4*)(part + (size_t)row * 16 + 4 * fq);
    float s = (p[0] + p[1]) + (p[2] + p[3]);
    s += __shfl_xor(s, 16); s += __shfl_xor(s, 32);
    return __builtin_amdgcn_rsqf(s * (1.0f / 1024.0f) + 1e-6f);
}
struct EpiProj {
    static constexpr bool PERM = true, AFTER_DRAIN = false;
    bf16_t* proj; const float* part; float* kp; float* vp; int ldp;
    __device__ __forceinline__ void operator()(const f32x4 (&acc)[2][2][4][2], const Unit& u, int wr, int wc, int fr, int fq) const {
        const int row0 = u.pm * BM + wr * 64 + fr, cw = wc * 32 + 8 * fq;
        const bool iskv = (u.pn == 3) || (u.pn == 4);
        float* kvp = (u.pn == 3) ? kp : vp;
#pragma unroll
        for (int ai = 0; ai < 2; ++ai)
#pragma unroll
            for (int m = 0; m < 4; ++m) {
                const int row = row0 + ai * HALF + m * 16;
                const float r = row_rs(part, row, fq);
                bf16_t* rowp = proj + (size_t)row * ldp + u.pn * BM + cw;
#pragma unroll
                for (int bj = 0; bj < 2; ++bj) {
                    const f32x4 v0 = acc[ai][bj][m][0] * r, v1 = acc[ai][bj][m][1] * r;
                    u32x4 w; w.x = cvt_pk_bf16(v0[0], v0[1]); w.y = cvt_pk_bf16(v0[2], v0[3]); w.z = cvt_pk_bf16(v1[0], v1[1]); w.w = cvt_pk_bf16(v1[2], v1[3]);
                    *(u32x4*)(rowp + bj * HALF) = w;
                    if (iskv) {
                        const int c = bj * HALF + cw;
                        float* d = kvp + (size_t)row * 256 + c; *(f32x4*)d = v0; *(f32x4*)(d + 4) = v1;
                    }
                }
            }
    }
};
struct EpiRes {
    static constexpr bool PERM = true, AFTER_DRAIN = false;
    const float* basep; float* X; bf16_t* xnb; float* part;
    __device__ __forceinline__ void operator()(const f32x4 (&acc)[2][2][4][2], const Unit& u, int wr, int wc, int fr, int fq) const {
        const int row0 = u.pm * BM + wr * 64 + fr, colt = u.pn * BM + wc * 32 + 8 * fq;
#pragma unroll
        for (int ai = 0; ai < 2; ++ai)
#pragma unroll
            for (int m = 0; m < 4; ++m) {
                const int row = row0 + ai * HALF + m * 16;
                const float* bp = basep + (size_t)row * 1024;
                float ss = 0.f;
#pragma unroll
                for (int bj = 0; bj < 2; ++bj) {
                    const int c = colt + bj * HALF;
                    f32x4 v0 = acc[ai][bj][m][0], v1 = acc[ai][bj][m][1];
                    v0 += *(const f32x4*)(bp + c); v1 += *(const f32x4*)(bp + c + 4);
                    float* xo = X + (size_t)row * 1024 + c; *(f32x4*)xo = v0; *(f32x4*)(xo + 4) = v1;
                    u32x4 w; w.x = cvt_pk_bf16(v0[0], v0[1]); w.y = cvt_pk_bf16(v0[2], v0[3]); w.z = cvt_pk_bf16(v1[0], v1[1]); w.w = cvt_pk_bf16(v1[2], v1[3]);
                    *(u32x4*)(xnb + (size_t)row * 1024 + c) = w;
                    ss += (v0[0] * v0[0] + v0[1] * v0[1]) + (v0[2] * v0[2] + v0[3] * v0[3]) + (v1[0] * v1[0] + v1[1] * v1[1]) + (v1[2] * v1[2] + v1[3] * v1[3]);
                }
                ss += __shfl_xor(ss, 16); ss += __shfl_xor(ss, 32);
                if (fq == 0) part[(size_t)row * 16 + u.pn * 4 + wc] = ss;
            }
    }
};
struct EpiSwiGLU {
    static constexpr bool PERM = true, AFTER_DRAIN = false;
    bf16_t* act; const float* part; int lda;
    __device__ __forceinline__ void operator()(const f32x4 (&acc)[2][2][4][2], const Unit& u, int wr, int wc, int fr, int fq) const {
        const int row0 = u.pm * BM + wr * 64 + fr, colt = u.pn * HALF + wc * 32 + 8 * fq;
#pragma unroll
        for (int ai = 0; ai < 2; ++ai)
#pragma unroll
            for (int m = 0; m < 4; ++m) {
                const int row = row0 + ai * HALF + m * 16;
                const float r = row_rs(part, row, fq);
                float o[8];
#pragma unroll
                for (int n = 0; n < 2; ++n)
#pragma unroll
                    for (int j = 0; j < 4; ++j) {
                        const float g = acc[ai][0][m][n][j] * r, uu = acc[ai][1][m][n][j] * r;
                        o[4 * n + j] = g * __builtin_amdgcn_rcpf(1.0f + __expf(-g)) * uu;
                    }
                u32x4 w; w.x = cvt_pk_bf16(o[0], o[1]); w.y = cvt_pk_bf16(o[2], o[3]); w.z = cvt_pk_bf16(o[4], o[5]); w.w = cvt_pk_bf16(o[6], o[7]);
                *(u32x4*)(act + (size_t)row * lda + colt) = w;
            }
    }
};

template <class Epi, class Sched, bool ALIGN_EPI = false, bool SP2 = false>
__device__ __forceinline__ void gemm_phase(PG8_LAS unsigned char* lds, const Gemm g, const Sched& S, const Epi& E, const int tid) {
    const int wid = __builtin_amdgcn_readfirstlane(tid >> 6), lane = tid & 63, wr = wid >> 2, wc = wid & 3, fr = lane & 15, fq = lane >> 4;
    const int K = g.K, nt = K / BK;
    unsigned voffA[2], voffB[2];
#pragma unroll
    for (int i = 0; i < 2; ++i) { int R, C; stage_rc(tid * 16 + i * 8192, R, C); const int Rb = Epi::PERM ? ((R & ~31) + perm32(R & 31)) : R;
        voffA[i] = (unsigned)(R * K + C) * 2u; voffB[i] = (unsigned)(Rb * K + C) * 2u; }
    const size_t kstep = (size_t)(BK * 2);
    const size_t hstep = (size_t)HALF * K * 2;
    const size_t tstep = 2 * hstep;
    const unsigned ldsw = (unsigned)wid * 1024u;
    const int aoff = lds_byte(wr * 64 + fr, fq * 8), boff = lds_byte(wc * 32 + fr, fq * 8);
#define PG8_SA(b, h) (((b) * 2 + (h)) * HTB)
#define PG8_SB(b, h) ((4 + (b) * 2 + (h)) * HTB)
#define PG8_STAGE(bufoff, gbase, voff) do { _Pragma("unroll") for (int _i = 0; _i < 2; ++_i) \
        __builtin_amdgcn_global_load_lds((const unsigned*)((const char*)(gbase) + (voff)[_i]), (PG8_LAS unsigned*)(lds + (bufoff) + ldsw + _i * 8192), 16, 0, 0); } while (0)
#define PG8_LDA(dst, b, h) do { _Pragma("unroll") for (int m = 0; m < 4; ++m) _Pragma("unroll") for (int k = 0; k < 2; ++k) dst[m][k] = *(const PG8_LAS bf16x8*)(lds + PG8_SA(b, h) + aoff + m * 2048 + k * 1024); } while (0)
#define PG8_LDB(dst, b, h) do { _Pragma("unroll") for (int n = 0; n < 2; ++n) _Pragma("unroll") for (int k = 0; k < 2; ++k) dst[n][k] = *(const PG8_LAS bf16x8*)(lds + PG8_SB(b, h) + boff + n * 2048 + k * 1024); } while (0)
#define PG8_MMA(ai, bj, At, Bt) do { __builtin_amdgcn_s_setprio(1); _Pragma("unroll") for (int m = 0; m < 4; ++m) _Pragma("unroll") for (int n = 0; n < 2; ++n) _Pragma("unroll") for (int k = 0; k < 2; ++k) \
        acc[ai][bj][m][n] = __builtin_amdgcn_mfma_f32_16x16x32_bf16(Bt[n][k], At[m][k], acc[ai][bj][m][n], 0, 0, 0); __builtin_amdgcn_s_setprio(0); } while (0)
#define PG8_WAIT_V(n) asm volatile("s_waitcnt vmcnt(" #n ")" ::: "memory")
#define PG8_WAIT_L(n) asm volatile("s_waitcnt lgkmcnt(" #n ")" ::: "memory")
#define PG8_BAR __builtin_amdgcn_s_barrier()
#define PG8_SCHED __builtin_amdgcn_sched_barrier(0)
    Unit cur, nxt; int ui = 0;
    if (!S.next(0, cur)) return;
    f32x4 acc[2][2][4][2];
#pragma unroll
    for (int a = 0; a < 2; ++a)
#pragma unroll
        for (int b = 0; b < 2; ++b)
#pragma unroll
            for (int m = 0; m < 4; ++m)
#pragma unroll
                for (int n = 0; n < 2; ++n) acc[a][b][m][n] = (f32x4){0.f, 0.f, 0.f, 0.f};
    bf16x8 At[4][2], B0[2][2], B1[2][2];
    const char* cA = (const char*)g.A + (size_t)cur.pm * tstep; const char* cB = (const char*)g.Bt + (size_t)cur.pn * tstep;
    S.a_ready(cur);
    if constexpr (SP2) {
        PG8_STAGE(PG8_SB(0, 0), cB, voffB); PG8_STAGE(PG8_SB(0, 1), cB + hstep, voffB); PG8_STAGE(PG8_SA(0, 0), cA, voffA); PG8_STAGE(PG8_SA(0, 1), cA + hstep, voffA);
        if (wr == 1) PG8_BAR;
        PG8_WAIT_V(2); PG8_BAR;
        PG8_STAGE(PG8_SB(1, 0), cB + kstep, voffB); PG8_STAGE(PG8_SA(1, 0), cA + kstep, voffA); PG8_STAGE(PG8_SB(1, 1), cB + hstep + kstep, voffB);
        PG8_WAIT_V(6); PG8_BAR;
    } else {
        PG8_STAGE(PG8_SB(0, 0), cB, voffB); PG8_STAGE(PG8_SA(0, 0), cA, voffA); PG8_STAGE(PG8_SB(0, 1), cB + hstep, voffB); PG8_STAGE(PG8_SA(0, 1), cA + hstep, voffA);
        if (wr == 1) PG8_BAR;
        PG8_WAIT_V(4); PG8_BAR;
        PG8_STAGE(PG8_SB(1, 0), cB + kstep, voffB); PG8_STAGE(PG8_SA(1, 0), cA + kstep, voffA); PG8_STAGE(PG8_SB(1, 1), cB + hstep + kstep, voffB);
        PG8_WAIT_V(6); PG8_BAR;
    }
    for (;;) {
        const bool has_next = S.next(ui + 1, nxt);
        const char* nA = has_next ? (const char*)g.A + (size_t)nxt.pm * tstep : cA; const char* nB = has_next ? (const char*)g.Bt + (size_t)nxt.pn * tstep : cB;
        for (int t = 0; t < nt; t += 2) {
            const bool last = (t == nt - 2);
            const char* a1 = cA + (size_t)(t + 1) * kstep;
            const char* a2 = last ? nA : cA + (size_t)(t + 2) * kstep; const char* b2 = last ? nB : cB + (size_t)(t + 2) * kstep;
            const char* a3 = a2 + kstep; const char* b3 = b2 + kstep;
            if (last && has_next) S.a_ready(nxt);
            if constexpr (SP2) {
            PG8_LDB(B0, 0, 0); PG8_LDB(B1, 0, 1); PG8_SCHED; PG8_LDA(At, 0, 0); PG8_STAGE(PG8_SA(1, 1), a1 + hstep, voffA);
            PG8_WAIT_V(8); PG8_WAIT_L(0); PG8_BAR; PG8_MMA(0, 0, At, B0); PG8_MMA(0, 1, At, B1); PG8_BAR; PG8_SCHED;
            PG8_LDA(At, 0, 1); PG8_STAGE(PG8_SB(0, 0), b2, voffB); PG8_STAGE(PG8_SB(0, 1), b2 + hstep, voffB); PG8_STAGE(PG8_SA(0, 0), a2, voffA);
            PG8_WAIT_V(8); PG8_WAIT_L(0); PG8_BAR; PG8_MMA(1, 0, At, B0); PG8_MMA(1, 1, At, B1); PG8_BAR; PG8_SCHED;
            PG8_LDB(B0, 1, 0); PG8_LDB(B1, 1, 1); PG8_SCHED; PG8_LDA(At, 1, 0); PG8_STAGE(PG8_SA(0, 1), a2 + hstep, voffA);
            PG8_WAIT_V(8); PG8_WAIT_L(0); PG8_BAR; PG8_MMA(0, 0, At, B0); PG8_MMA(0, 1, At, B1); PG8_BAR; PG8_SCHED;
            PG8_LDA(At, 1, 1); PG8_STAGE(PG8_SB(1, 0), b3, voffB); PG8_STAGE(PG8_SB(1, 1), b3 + hstep, voffB); PG8_STAGE(PG8_SA(1, 0), a3, voffA);
            PG8_WAIT_V(8); PG8_WAIT_L(0); PG8_BAR; PG8_MMA(1, 0, At, B0); PG8_MMA(1, 1, At, B1); PG8_BAR; PG8_SCHED;
            } else {
            PG8_LDB(B0, 0, 0); PG8_SCHED; PG8_LDA(At, 0, 0); PG8_STAGE(PG8_SA(1, 1), a1 + hstep, voffA);
            PG8_WAIT_L(8); PG8_BAR; PG8_WAIT_L(0); PG8_MMA(0, 0, At, B0); PG8_BAR; PG8_SCHED;
            PG8_LDB(B1, 0, 1); PG8_STAGE(PG8_SB(0, 0), b2, voffB);
            PG8_BAR; PG8_WAIT_L(0); PG8_MMA(0, 1, At, B1); PG8_BAR;
            PG8_LDA(At, 0, 1); PG8_STAGE(PG8_SA(0, 0), a2, voffA);
            PG8_BAR; PG8_WAIT_L(0); PG8_MMA(1, 0, At, B0); PG8_BAR; PG8_SCHED;
            PG8_STAGE(PG8_SB(0, 1), b2 + hstep, voffB);
            PG8_WAIT_V(6); PG8_BAR; PG8_MMA(1, 1, At, B1); PG8_BAR;
            PG8_LDB(B0, 1, 0); PG8_SCHED; PG8_LDA(At, 1, 0); PG8_STAGE(PG8_SA(0, 1), a2 + hstep, voffA);
            PG8_WAIT_L(8); PG8_BAR; PG8_WAIT_L(0); PG8_MMA(0, 0, At, B0); PG8_BAR; PG8_SCHED;
            PG8_LDB(B1, 1, 1); PG8_STAGE(PG8_SB(1, 0), b3, voffB);
            PG8_BAR; PG8_WAIT_L(0); PG8_MMA(0, 1, At, B1); PG8_BAR;
            PG8_LDA(At, 1, 1); PG8_STAGE(PG8_SA(1, 0), a3, voffA);
            PG8_BAR; PG8_WAIT_L(0); PG8_MMA(1, 0, At, B0); PG8_BAR; PG8_SCHED;
            PG8_STAGE(PG8_SB(1, 1), b3 + hstep, voffB);
            PG8_WAIT_V(6); PG8_BAR; PG8_MMA(1, 1, At, B1); PG8_BAR;
            }
        }
        if constexpr (ALIGN_EPI) { if (wr == 0) PG8_BAR; }
        if constexpr (!Epi::AFTER_DRAIN) { E(acc, cur, wr, wc, fr, fq); S.done(cur); }
        if (!has_next) break;
#pragma unroll
        for (int a = 0; a < 2; ++a)
#pragma unroll
            for (int b = 0; b < 2; ++b)
#pragma unroll
                for (int m = 0; m < 4; ++m)
#pragma unroll
                    for (int n = 0; n < 2; ++n) acc[a][b][m][n] = (f32x4){0.f, 0.f, 0.f, 0.f};
        cur = nxt; cA = nA; cB = nB; ++ui;
        if constexpr (ALIGN_EPI) { if (wr == 1) PG8_BAR; }
    }
    PG8_WAIT_V(0);
    if constexpr (!ALIGN_EPI) { if (wr == 0) PG8_BAR; }
    PG8_BAR;
    if constexpr (Epi::AFTER_DRAIN) { E.fused(acc, cur, wr, wc, fr, fq, lds, wid, lane); S.done(cur); }
#undef PG8_SA
#undef PG8_SB
#undef PG8_STAGE
#undef PG8_LDA
#undef PG8_LDB
#undef PG8_MMA
#undef PG8_WAIT_V
#undef PG8_WAIT_L
#undef PG8_BAR
#undef PG8_SCHED
}
}

constexpr int NWAVES = 8;
constexpr size_t MiB = 1u << 20;
constexpr size_t WS_CTL = 0, CTL_ZERO_BYTES = 1 * MiB;
constexpr size_t WS_PART1 = 1 * MiB, WS_PART2 = 3 * MiB, WS_LSE = 5 * MiB;
constexpr size_t WS_W = 8 * MiB;
constexpr size_t W_IN = 0, W_OUT = (size_t)NPROJ * DM * 2, W_GU = W_OUT + (size_t)DM * DM * 2, W_DN = W_GU + (size_t)NGU * DM * 2, W_LAYER = W_DN + (size_t)DM * FFD * 2;
static_assert(W_LAYER == 23 * MiB, "weights per layer");
constexpr size_t WS_XB = 56 * MiB, WS_X1B = 89 * MiB, WS_MIX = 122 * MiB;
constexpr size_t WS_X = 155 * MiB;
constexpr size_t WS_PROJ = 220 * MiB;
constexpr size_t WS_ATTO = 294 * MiB;
constexpr size_t WS_ACT = 220 * MiB;
constexpr size_t WS_END = 344 * MiB;
static_assert(WS_PROJ + (size_t)MPAD * NPROJ * 2 <= WS_ATTO && WS_ATTO + (size_t)3 * MPAD * 256 * 4 <= WS_END && WS_ACT + (size_t)MPAD * FFD * 2 <= WS_END, "ws map");
static_assert(WS_X + (size_t)MPAD * DM * 4 <= WS_PROJ && WS_MIX + (size_t)MPAD * DM * 2 <= WS_X && WS_W + 2 * W_LAYER <= WS_XB, "ws map 2");
constexpr int CW_BAR = 4096;

constexpr int RING_OFF = 0, RING_BYTES = 131072;
constexpr int LDSCTL_OFF = RING_BYTES, MISC_OFF = LDSCTL_OFF + 320;
constexpr int LDS_BYTES = 147456;

#define GAS __attribute__((address_space(1)))
#define LAS __attribute__((address_space(3)))
typedef unsigned short bf16;
typedef unsigned v4u __attribute__((ext_vector_type(4)));
typedef unsigned v2u __attribute__((ext_vector_type(2)));
typedef float f32x4 __attribute__((ext_vector_type(4)));
typedef float f32x16 __attribute__((ext_vector_type(16)));
typedef short bf16x8 __attribute__((ext_vector_type(8)));
typedef short s16x4 __attribute__((ext_vector_type(4)));
typedef GAS unsigned gu32;
#define LDS_WAIT() asm volatile("s_waitcnt lgkmcnt(0)" ::: "memory")
#define VM_WAIT() asm volatile("s_waitcnt vmcnt(0)" ::: "memory")
__device__ __forceinline__ unsigned f2bf(float f) { unsigned u = __builtin_bit_cast(unsigned, f); return (u + 0x7fffu + ((u >> 16) & 1u)) >> 16; }
__device__ __forceinline__ unsigned pk2(float lo, float hi) { return pg8::cvt_pk_bf16(lo, hi); }
__device__ __forceinline__ float bflo(unsigned w) { return __builtin_bit_cast(float, w << 16); }
__device__ __forceinline__ float bfhi(unsigned w) { return __builtin_bit_cast(float, w & 0xffff0000u); }
__device__ __forceinline__ void unpack8(const v4u w, float* f) { f[0] = bflo(w.x); f[1] = bfhi(w.x); f[2] = bflo(w.y); f[3] = bfhi(w.y); f[4] = bflo(w.z); f[5] = bfhi(w.z); f[6] = bflo(w.w); f[7] = bfhi(w.w); }
__device__ __forceinline__ v4u pack8(const float* f) { v4u w; w.x = pk2(f[0], f[1]); w.y = pk2(f[2], f[3]); w.z = pk2(f[4], f[5]); w.w = pk2(f[6], f[7]); return w; }
__device__ __forceinline__ float sigmoidf_(float x) { return __builtin_amdgcn_rcpf(1.0f + __expf(-x)); }
__device__ __forceinline__ float wave_sum(float v) {
#pragma unroll
    for (int o = 1; o < 64; o <<= 1) v += __shfl_xor(v, o);
    return v;
}
__device__ __forceinline__ float wave_max(float v) {
#pragma unroll
    for (int o = 1; o < 64; o <<= 1) v = fmaxf(v, __shfl_xor(v, o));
    return v;
}

#define XB_TMO      128
#define XB_XCNT(j)  (256  + 64 * (j))
#define XB_XSUB(j)  (1280 + 64 * (j))
#define XB_XGEN(j)  (2304 + 64 * (j))
#define XB_TOP      3328
#define XB_TOPGEN   3392
#define XCD_BAR_WORDS 3456
#define XB_SPIN_CAP (1u << 18)

__device__ __forceinline__ unsigned xb_ld(unsigned* p)              { return __hip_atomic_load(p, __ATOMIC_RELAXED, __HIP_MEMORY_SCOPE_AGENT); }
__device__ __forceinline__ unsigned xb_add(unsigned* p, unsigned v) { return __hip_atomic_fetch_add(p, v, __ATOMIC_RELAXED, __HIP_MEMORY_SCOPE_AGENT); }
__device__ __forceinline__ unsigned xb_xcc_id() { return (unsigned)__builtin_amdgcn_s_getreg((3 << 11) | 20) & 0xFu; }
#define XB_SPIN(cond, bar) do { unsigned _sp = 0; while (cond) { __builtin_amdgcn_s_sleep(1); \
    if ((++_sp & 255u) == 0u) { if (xb_ld(&(bar)[XB_TMO])) break; if (_sp > XB_SPIN_CAP) { atomicAdd(&(bar)[XB_TMO], 1u); break; } } } } while (0)

struct XcdBarrier {
    unsigned* bar; unsigned x;
    volatile LAS unsigned* st;
};
__device__ __forceinline__ XcdBarrier xcd_barrier_post(unsigned* bar, volatile LAS unsigned* st) {
    XcdBarrier b; b.bar = bar; b.x = xb_xcc_id(); b.st = st;
    if (threadIdx.x == 0) (void)xb_add(&bar[XB_XCNT(b.x)], 1u);
    return b;
}
__device__ __forceinline__ void xcd_barrier_complete(unsigned* bar, unsigned x, unsigned& nloc, unsigned& nx) {
    const unsigned G = gridDim.x * gridDim.y * gridDim.z;
    unsigned sum, cnt, mine, sp = 0u;
    for (;;) {
        sum = 0u; cnt = 0u; mine = 0u;
#pragma unroll
        for (unsigned j = 0; j < 16; ++j) { const unsigned c = xb_ld(&bar[XB_XCNT(j)]); sum += c; cnt += (c > 0u) ? 1u : 0u; mine = (j == x) ? c : mine; }
        if (sum == G) break;
        __builtin_amdgcn_s_sleep(1);
        if ((++sp & 255u) == 0u) { if (xb_ld(&bar[XB_TMO])) break; if (sp > XB_SPIN_CAP) { atomicAdd(&bar[XB_TMO], 1u); break; } }
    }
    nloc = mine > 0u ? mine : 1u; nx = cnt > 0u ? cnt : 1u;
}
__device__ __forceinline__ void xcd_barrier(const XcdBarrier& b) {
    asm volatile("s_waitcnt vmcnt(0)" ::: "memory");
    __syncthreads();
    if (threadIdx.x == 0) {
        unsigned* bar = b.bar;
        __builtin_amdgcn_s_waitcnt(0);
        unsigned nloc = b.st[0], nx = b.st[1];
        if (nloc == 0u) { xcd_barrier_complete(bar, b.x, nloc, nx); b.st[0] = nloc; b.st[1] = nx; }
        const unsigned old = xb_add(&bar[XB_XSUB(b.x)], 1u);
        const unsigned gen = old / nloc;
        if (old + 1u == (gen + 1u) * nloc) {
            __builtin_amdgcn_fence(__ATOMIC_RELEASE, "agent");
            asm volatile("s_waitcnt vmcnt(0)" ::: "memory");
            const unsigned og = xb_add(&bar[XB_TOP], 1u);
            const unsigned tg = og / nx;
            if (og + 1u == (tg + 1u) * nx) xb_add(&bar[XB_TOPGEN], 1u);
            else XB_SPIN(xb_ld(&bar[XB_TOPGEN]) == tg, bar);
            __builtin_amdgcn_fence(__ATOMIC_ACQUIRE, "agent");
            xb_add(&bar[XB_XGEN(b.x)], 1u);
            asm volatile("s_waitcnt vmcnt(0)" ::: "memory");
        } else {
            XB_SPIN(xb_ld(&bar[XB_XGEN(b.x)]) == gen, bar);
            __builtin_amdgcn_fence(__ATOMIC_ACQUIRE, "agent");
            asm volatile("s_waitcnt vmcnt(0)" ::: "memory");
        }
    }
    __syncthreads();
}

struct Args { const float* in[21]; float* out; unsigned char* ws; };
typedef __attribute__((address_space(4))) const unsigned char* kaptr_t;
struct Frame {
    LAS unsigned char* lds;
    int tid, lane, wave, G, vcu;
    kaptr_t ka;
    float* out; unsigned char* ws;
    __device__ __forceinline__ const float* inp(int i) const { return *(const float* const __attribute__((address_space(4)))*)(ka + 8 * i); }
};
__device__ __forceinline__ void launder(Frame& F) {
    asm volatile("" : "+s"(F.ka), "+s"(F.G), "+s"(F.vcu), "+v"(F.tid));
    F.lane = F.tid & 63; F.wave = __builtin_amdgcn_readfirstlane(F.tid >> 6);
    F.out = *(float* const __attribute__((address_space(4)))*)(F.ka + 8 * 21);
    F.ws = *(unsigned char* const __attribute__((address_space(4)))*)(F.ka + 8 * 22);
}
enum { I_XP = 0, I_XS, I_CK, I_CV, I_SA, I_SC, I_SP, I_WIN, I_CAW, I_CAB, I_LNG, I_LNB, I_CCW, I_PW, I_PS, I_WOUT, I_N1, I_N2, I_WGU, I_WDN, I_FG };

__device__ __forceinline__ void tr_item(const float* W, int ldw, int k0, int srccol0, const float* ksc, bf16* WT, int K, int dstrow0, LAS float* scr, int lane) {
#pragma unroll 8
    for (int i = 0; i < 32; ++i) { const int kk = 2 * i + (lane >> 5); float v = W[(size_t)(k0 + kk) * ldw + srccol0 + (lane & 31)]; if (ksc) v *= ksc[k0 + kk]; scr[kk * 33 + (lane & 31)] = v; }
    LDS_WAIT(); asm volatile("" ::: "memory");
    const int c = lane & 7;
#pragma unroll
    for (int j = 0; j < 4; ++j) { const int n = (lane >> 3) + 8 * j; const LAS float* s = scr + (8 * c) * 33 + n;
        v4u o; o.x = pk2(s[0 * 33], s[1 * 33]); o.y = pk2(s[2 * 33], s[3 * 33]); o.z = pk2(s[4 * 33], s[5 * 33]); o.w = pk2(s[6 * 33], s[7 * 33]);
        *(GAS v4u*)(WT + (size_t)(dstrow0 + n) * K + k0 + 8 * c) = o; }
    LDS_WAIT(); asm volatile("" ::: "memory");
}
__device__ __forceinline__ void pool_fold_item(const float* wout, const float* pw, const float* ps, bf16* WT, int g, int n0, LAS float* scr, int lane) {
#pragma unroll 8
    for (int i = 0; i < 32; ++i) { const int e = 2 * i + (lane >> 5); scr[e * 33 + (lane & 31)] = wout[(size_t)(768 + g * 64 + e) * DM + n0 + (lane & 31)] * ps[g * 64 + e]; }
    LDS_WAIT(); asm volatile("" ::: "memory");
    const int n = lane & 31, half = lane >> 5;
    for (int cb = 0; cb < 4; ++cb) {
        float o[8];
#pragma unroll
        for (int i = 0; i < 8; ++i) o[i] = 0.f;
        const float* pwr = pw + (size_t)(g * 64 + half * 32 + cb * 8) * 64;
        for (int e = 0; e < 64; ++e) { const float s = scr[e * 33 + n];
#pragma unroll
            for (int i = 0; i < 8; ++i) o[i] += pwr[i * 64 + e] * s; }
        *(GAS v4u*)(WT + (size_t)(n0 + n) * DM + 768 + g * 64 + half * 32 + cb * 8) = pack8(o);
    }
    LDS_WAIT(); asm volatile("" ::: "memory");
}
__device__ __forceinline__ void p0_prologue(Frame F) {
    launder(F);
    LAS float* scr = (LAS float*)(F.lds + RING_OFF + F.wave * 16384);
    const int gw = F.vcu * NWAVES + F.wave, NGW = F.G * NWAVES;
    constexpr int I_IN = 16 * 72, I_OUTP = 12 * 32, I_OUTF = 4 * 32, I_GU = 16 * 176, I_DN = 44 * 32, I_L = I_IN + I_OUTP + I_OUTF + I_GU + I_DN;
    for (int it = gw; it < 2 * I_L; it += NGW) {
        const int l = it / I_L; int r = it % I_L;
        bf16* wl = (bf16*)(F.ws + WS_W + (size_t)l * W_LAYER);
        if (r < I_IN) { const int kb = r / 72, nb = r % 72; tr_item(F.inp(I_WIN) + (size_t)l * DM * NPROJ, NPROJ, 64 * kb, 32 * nb, F.inp(I_N1) + l * DM, wl + W_IN / 2, DM, 32 * nb, scr, F.lane); continue; } r -= I_IN;
        if (r < I_OUTP) { const int kb = r / 32, nb = r % 32; tr_item(F.inp(I_WOUT) + (size_t)l * DM * DM, DM, 64 * kb, 32 * nb, nullptr, wl + W_OUT / 2, DM, 32 * nb, scr, F.lane); continue; } r -= I_OUTP;
        if (r < I_OUTF) { const int g = r / 32, nb = r % 32; pool_fold_item(F.inp(I_WOUT) + (size_t)l * DM * DM, F.inp(I_PW) + (size_t)l * 4 * 64 * 64, F.inp(I_PS) + l * GW, wl + W_OUT / 2, g, 32 * nb, scr, F.lane); continue; } r -= I_OUTF;
        if (r < I_GU) { const int kb = r / 176, nb = r % 176; const int R = 32 * nb, pn = R >> 8, bj = (R >> 7) & 1, j0 = R & 127;
            tr_item(F.inp(I_WGU) + (size_t)l * DM * NGU, NGU, 64 * kb, bj * FFD + 128 * pn + j0, F.inp(I_N2) + l * DM, wl + W_GU / 2, DM, R, scr, F.lane); continue; } r -= I_GU;
        { const int kb = r / 32, nb = r % 32; tr_item(F.inp(I_WDN) + (size_t)l * FFD * DM, DM, 64 * kb, 32 * nb, nullptr, wl + W_DN / 2, FFD, 32 * nb, scr, F.lane); }
    }
    bf16* xb = (bf16*)(F.ws + WS_XB); float* part1 = (float*)(F.ws + WS_PART1);
    for (int m = gw; m < MPAD; m += NGW) {
        const float* src = m < MP ? F.inp(I_XP) + (size_t)m * DM : (m < MP + MS ? F.inp(I_XS) + (size_t)(m - MP) * DM : nullptr);
        f32x4 v[4]; float s = 0.f;
#pragma unroll
        for (int j = 0; j < 4; ++j) { v[j] = src ? ((const GAS f32x4*)src)[F.lane + 64 * j] : (f32x4){0.f, 0.f, 0.f, 0.f}; s += (v[j].x * v[j].x + v[j].y * v[j].y) + (v[j].z * v[j].z + v[j].w * v[j].w); }
        s = wave_sum(s);
        GAS v2u* o8 = (GAS v2u*)(xb + (size_t)m * DM) + F.lane;
#pragma unroll
        for (int j = 0; j < 4; ++j) { v2u w; w.x = pk2(v[j].x, v[j].y); w.y = pk2(v[j].z, v[j].w); o8[64 * j] = w; }
        if (F.lane < 16) part1[(size_t)m * 16 + F.lane] = F.lane == 0 ? s : 0.f;
    }
    {
        const size_t NT = (size_t)F.G * NWAVES * 64, t0 = (size_t)F.vcu * NWAVES * 64 + F.tid;
        constexpr size_t SEGV = 2047 * 64;
        for (size_t i = t0; i < (size_t)128 * SEGV; i += NT) {
            const int seg = (int)(i / SEGV); const size_t off = i - (size_t)seg * SEGV; const int kv = seg >> 6, lb = seg & 63;
            const f32x4* src = (const f32x4*)(F.inp(kv ? I_CV : I_CK)) + (size_t)lb * 131072 + 64 + off;
            f32x4* dst = (f32x4*)(F.out + (kv ? O_VS : O_KS)) + (size_t)lb * 131072 + off;
            __builtin_nontemporal_store(__builtin_nontemporal_load(src), dst);
        }
    }
}

__device__ __forceinline__ int crow(int r, int hi) { return (r & 3) + 8 * (r >> 2) + 4 * hi; }
__device__ __forceinline__ void attn_prompt_task(const bf16* proj, float* atto, float* lse, int task, LAS unsigned char* vbuf, int lane) {
    const int j = task & 63, t2 = task >> 6, cfg = t2 % 3, bh = t2 / 3, h = bh & 3, b = bh >> 2;
    const int sh = 2 * cfg, nqs = 6 - sh, r = j >> nqs, qt = j & ((1 << nqs) - 1);
    const int c = lane & 31, hh = lane >> 5;
    const size_t rowb = (size_t)b * SEQ;
    const float sc2 = 0.125f * 1.4426950408889634f;
    bf16x8 qf[4];
    { const bf16* qp = proj + (rowb + (((32 * qt + c) << sh) + r)) * NPROJ + C_Q + h * 64 + 8 * hh;
#pragma unroll
      for (int s = 0; s < 4; ++s) qf[s] = *(const GAS bf16x8*)(qp + 16 * s); }
    f32x16 O0, O1;
#pragma unroll
    for (int i = 0; i < 16; ++i) { O0[i] = 0.f; O1[i] = 0.f; }
    float mrun = -1e30f, lsum = 0.f;
    const int kt_lo = qt > 4 ? qt - 4 : 0;
    const int trb = (4 * hh + ((lane & 15) >> 2)) * 64 + (16 * ((lane >> 4) & 1) + 4 * (lane & 3)) * 2;
    bf16x8 kfn[4]; v4u vvn[4];
    { const int kt = kt_lo;
      const bf16* kp = proj + (rowb + (((32 * kt + c) << sh) + r)) * NPROJ + C_K + h * 64 + 8 * hh;
#pragma unroll
      for (int s = 0; s < 4; ++s) kfn[s] = *(const GAS bf16x8*)(kp + 16 * s);
#pragma unroll
      for (int i = 0; i < 4; ++i) { const int id = lane + 64 * i, key = id >> 3, ch = id & 7;
          vvn[i] = *(const GAS v4u*)(proj + (rowb + (((32 * kt + key) << sh) + r)) * NPROJ + C_V + h * 64 + ch * 8); } }
    for (int kt = kt_lo; kt <= qt; ++kt) {
        bf16x8 kf[4]; v4u vv[4];
#pragma unroll
        for (int s = 0; s < 4; ++s) { kf[s] = kfn[s]; vv[s] = vvn[s]; }
        if (kt < qt) {
            const bf16* kp = proj + (rowb + (((32 * (kt + 1) + c) << sh) + r)) * NPROJ + C_K + h * 64 + 8 * hh;
#pragma unroll
            for (int s = 0; s < 4; ++s) kfn[s] = *(const GAS bf16x8*)(kp + 16 * s);
#pragma unroll
            for (int i = 0; i < 4; ++i) { const int id = lane + 64 * i, key = id >> 3, ch = id & 7;
                vvn[i] = *(const GAS v4u*)(proj + (rowb + (((32 * (kt + 1) + key) << sh) + r)) * NPROJ + C_V + h * 64 + ch * 8); }
        }
        f32x16 S;
#pragma unroll
        for (int i = 0; i < 16; ++i) S[i] = 0.f;
#pragma unroll
        for (int s = 0; s < 4; ++s) S = __builtin_amdgcn_mfma_f32_32x32x16_bf16(kf[s], qf[s], S, 0, 0, 0);
        float x[16];
        if (kt == qt || kt == qt - 4) {
            const int relb = 32 * (qt - kt) + c;
#pragma unroll
            for (int i = 0; i < 16; ++i) { const int rel = relb - crow(i, hh); x[i] = (rel >= 0 && rel <= 128) ? S[i] * sc2 : -1e30f; }
        } else {
#pragma unroll
            for (int i = 0; i < 16; ++i) x[i] = S[i] * sc2;
        }
        float mx = x[0];
#pragma unroll
        for (int i = 1; i < 16; ++i) mx = fmaxf(mx, x[i]);
        mx = fmaxf(mx, __shfl_xor(mx, 32));
        const float mnew = fmaxf(mrun, mx), alpha = __builtin_amdgcn_exp2f(mrun - mnew);
        mrun = mnew;
        float ps = 0.f;
#pragma unroll
        for (int i = 0; i < 16; ++i) { x[i] = __builtin_amdgcn_exp2f(x[i] - mnew); ps += x[i]; }
        lsum = lsum * alpha + ps;
#pragma unroll
        for (int i = 0; i < 16; ++i) { O0[i] *= alpha; O1[i] *= alpha; }
        bf16x8 pb[2];
#pragma unroll
        for (int s = 0; s < 2; ++s) { v4u w; w.x = pk2(x[8 * s + 0], x[8 * s + 1]); w.y = pk2(x[8 * s + 2], x[8 * s + 3]); w.z = pk2(x[8 * s + 4], x[8 * s + 5]); w.w = pk2(x[8 * s + 6], x[8 * s + 7]); pb[s] = __builtin_bit_cast(bf16x8, w); }
#pragma unroll
        for (int i = 0; i < 4; ++i) { const int id = lane + 64 * i, key = id >> 3, ch = id & 7;
            *(LAS v4u*)(vbuf + (ch >> 2) * 2048 + key * 64 + (ch & 3) * 16) = vv[i]; }
        asm volatile("s_waitcnt lgkmcnt(0)" ::: "memory");
#pragma unroll
        for (int s = 0; s < 2; ++s) {
            const s16x4 a00 = __builtin_bit_cast(s16x4, __builtin_amdgcn_ds_read_tr16_b64_v4i16((LAS s16x4*)(vbuf + trb + (16 * s) * 64)));
            const s16x4 a01 = __builtin_bit_cast(s16x4, __builtin_amdgcn_ds_read_tr16_b64_v4i16((LAS s16x4*)(vbuf + trb + (16 * s + 8) * 64)));
            const s16x4 a10 = __builtin_bit_cast(s16x4, __builtin_amdgcn_ds_read_tr16_b64_v4i16((LAS s16x4*)(vbuf + 2048 + trb + (16 * s) * 64)));
            const s16x4 a11 = __builtin_bit_cast(s16x4, __builtin_amdgcn_ds_read_tr16_b64_v4i16((LAS s16x4*)(vbuf + 2048 + trb + (16 * s + 8) * 64)));
            const bf16x8 A0 = __builtin_shufflevector(a00, a01, 0, 1, 2, 3, 4, 5, 6, 7), A1 = __builtin_shufflevector(a10, a11, 0, 1, 2, 3, 4, 5, 6, 7);
            O0 = __builtin_amdgcn_mfma_f32_32x32x16_bf16(A0, pb[s], O0, 0, 0, 0);
            O1 = __builtin_amdgcn_mfma_f32_32x32x16_bf16(A1, pb[s], O1, 0, 0, 0);
        }
        asm volatile("s_waitcnt lgkmcnt(0)" ::: "memory");
    }
    const float ltot = lsum + __shfl_xor(lsum, 32), inv = 1.0f / ltot;
    const size_t qrow = rowb + (((32 * qt + c) << sh) + r);
    float* op = atto + ((size_t)cfg * MPAD + qrow) * 256 + h * 64 + 4 * hh;
#pragma unroll
    for (int g = 0; g < 4; ++g) {
        *(GAS f32x4*)(op + 8 * g) = (f32x4){O0[4 * g] * inv, O0[4 * g + 1] * inv, O0[4 * g + 2] * inv, O0[4 * g + 3] * inv};
        *(GAS f32x4*)(op + 32 + 8 * g) = (f32x4){O1[4 * g] * inv, O1[4 * g + 1] * inv, O1[4 * g + 2] * inv, O1[4 * g + 3] * inv};
    }
    if (hh == 0) lse[((size_t)cfg * MPAD + qrow) * 4 + h] = mrun * 0.6931471805599453f + __logf(ltot);
}
__device__ __forceinline__ void attn_sample_task(const Frame& F, int l, int s, LAS float* pbuf) {
    const int h = s & 3, b = (s >> 2) & 31, cfg = s >> 7, dil = 1 << (2 * cfg), lane = F.lane;
    const bf16* proj = (const bf16*)(F.ws + WS_PROJ);
    const bf16* prow = proj + (size_t)(MP + b) * NPROJ;
    const float* ck = F.inp(I_CK) + ((size_t)(l * 32 + b) * BUF) * 256 + h * 64;
    const float* cv = F.inp(I_CV) + ((size_t)(l * 32 + b) * BUF) * 256 + h * 64;
    float q[64];
#pragma unroll
    for (int i = 0; i < 8; ++i) unpack8(*(const GAS v4u*)(prow + C_Q + h * 64 + 8 * i), q + 8 * i);
    float sc[3];
#pragma unroll
    for (int it = 0; it < 3; ++it) {
        const int i = lane + 64 * it; float d = 0.f;
        if (i <= 128) {
            if (i == 0) {
#pragma unroll
                for (int u = 0; u < 8; ++u) { float kk[8]; unpack8(*(const GAS v4u*)(prow + C_K + h * 64 + 8 * u), kk);
#pragma unroll
                    for (int e = 0; e < 8; ++e) d += q[8 * u + e] * kk[e]; }
            } else {
                const GAS f32x4* kr = (const GAS f32x4*)(ck + (size_t)(BUF - i * dil) * 256);
#pragma unroll
                for (int u = 0; u < 16; ++u) { const f32x4 kk = kr[u]; d += (q[4 * u] * kk.x + q[4 * u + 1] * kk.y) + (q[4 * u + 2] * kk.z + q[4 * u + 3] * kk.w); }
            }
            sc[it] = d * 0.125f;
        } else sc[it] = -1e30f;
    }
    const float m = wave_max(fmaxf(fmaxf(sc[0], sc[1]), sc[2]));
    float den = 0.f;
#pragma unroll
    for (int it = 0; it < 3; ++it) { const int i = lane + 64 * it; const float p = (i <= 128) ? __expf(sc[it] - m) : 0.f; den += p; if (i <= 128) pbuf[i] = p; }
    den = wave_sum(den);
    asm volatile("s_waitcnt lgkmcnt(0)" ::: "memory");
    float o = pbuf[0] * bflo((unsigned)prow[C_V + h * 64 + lane]);
    for (int i = 1; i <= 128; ++i) o += pbuf[i] * cv[(size_t)(BUF - i * dil) * 256 + lane];
    asm volatile("s_waitcnt lgkmcnt(0)" ::: "memory");
    float* atto = (float*)(F.ws + WS_ATTO); float* lse = (float*)(F.ws + WS_LSE);
    atto[((size_t)cfg * MPAD + MP + b) * 256 + h * 64 + lane] = o / den;
    if (lane == 0) lse[((size_t)cfg * MPAD + MP + b) * 4 + h] = m + __logf(den);
}
__device__ __forceinline__ void attn_phase(Frame F, int l) {
    launder(F); asm volatile("" : "+s"(l));
    const bf16* proj = (const bf16*)(F.ws + WS_PROJ); float* atto = (float*)(F.ws + WS_ATTO); float* lse = (float*)(F.ws + WS_LSE);
    const int gw = F.vcu * NWAVES + F.wave, NGW = F.G * NWAVES;
    LAS unsigned char* vbuf = F.lds + RING_OFF + F.wave * 8192;
    for (int t = gw; t < NB * 4 * 3 * 64; t += NGW) attn_prompt_task(proj, atto, lse, t, vbuf, F.lane);
    for (int s = gw; s < 3 * 32 * 4; s += NGW) attn_sample_task(F, l, s, (LAS float*)(vbuf + 4096));
}

__device__ __forceinline__ void mixer_prompt_tile(Frame& F, int l, int tile) {
    const bf16* proj = (const bf16*)(F.ws + WS_PROJ); bf16* mix = (bf16*)(F.ws + WS_MIX);
    const float* atto = (const float*)(F.ws + WS_ATTO); const float* lse = (const float*)(F.ws + WS_LSE);
    const int b = tile >> 6, t0 = (tile & 63) * 32, tid = F.tid, lane = F.lane;
    const size_t rowb = (size_t)b * SEQ;
    LAS float* ga = (LAS float*)(F.lds + RING_OFF);
    LAS float* yp = ga + 62 * 256;
    for (int it = tid; it < 62 * 32; it += NWAVES * 64) {
        const int rr = it >> 5, ch = it & 31, t = t0 - 30 + rr;
        float g8[8];
        if (t >= 0) { float a8[8], s8[8]; const bf16* pr = proj + (rowb + t) * NPROJ + ch * 8;
            unpack8(*(const GAS v4u*)(pr + C_AV), a8); unpack8(*(const GAS v4u*)(pr + C_AG), s8);
#pragma unroll
            for (int e = 0; e < 8; ++e) g8[e] = a8[e] * sigmoidf_(s8[e]);
        } else {
#pragma unroll
            for (int e = 0; e < 8; ++e) g8[e] = 0.f; }
        *(LAS f32x4*)(ga + rr * 256 + ch * 8) = (f32x4){g8[0], g8[1], g8[2], g8[3]}; *(LAS f32x4*)(ga + rr * 256 + ch * 8 + 4) = (f32x4){g8[4], g8[5], g8[6], g8[7]};
        if (t0 == SEQ - 32 && rr >= 32) { float* d = F.out + O_AP + ((size_t)(l * NB + b) * 30 + (rr - 32)) * 256 + ch * 8;
            *(GAS f32x4*)d = (f32x4){g8[0], g8[1], g8[2], g8[3]}; *(GAS f32x4*)(d + 4) = (f32x4){g8[4], g8[5], g8[6], g8[7]}; }
    }
    __syncthreads();
    {
        const int c = tid & 255, half = tid >> 8;
        const float* cw = F.inp(I_CAW) + (size_t)l * 31 * 256 + c;
        float w[31];
#pragma unroll
        for (int jj = 0; jj < 31; ++jj) w[jj] = cw[jj * 256];
        const float bias = F.inp(I_CAB)[l * 256 + c];
        float acc[16];
#pragma unroll
        for (int t = 0; t < 16; ++t) acc[t] = bias;
#pragma unroll
        for (int rr = 0; rr < 46; ++rr) { const float v = ga[(half * 16 + rr) * 256 + c];
#pragma unroll
            for (int t = 0; t < 16; ++t) { const int jj = rr - t; if (jj >= 0 && jj <= 30) acc[t] += w[jj] * v; } }
#pragma unroll
        for (int t = 0; t < 16; ++t) yp[(half * 16 + t) * 256 + c] = acc[t];
    }
    __syncthreads();
    {
        const f32x4 g4 = *(const GAS f32x4*)(F.inp(I_LNG) + l * 256 + 4 * lane), b4 = *(const GAS f32x4*)(F.inp(I_LNB) + l * 256 + 4 * lane);
#pragma unroll
        for (int tt = 0; tt < 4; ++tt) { const int tok = F.wave * 4 + tt;
            const f32x4 xv = *(LAS f32x4*)(yp + tok * 256 + 4 * lane);
            const float mean = wave_sum((xv.x + xv.y) + (xv.z + xv.w)) * (1.f / 256.f);
            const f32x4 d = xv - mean;
            const float var = wave_sum((d.x * d.x + d.y * d.y) + (d.z * d.z + d.w * d.w)) * (1.f / 256.f);
            const float rstd = __builtin_amdgcn_rsqf(var + EPSN);
            f32x4 y = d * rstd * g4 + b4;
            y.x *= sigmoidf_(y.x); y.y *= sigmoidf_(y.y); y.z *= sigmoidf_(y.z); y.w *= sigmoidf_(y.w);
            v2u w; w.x = pk2(y.x, y.y); w.y = pk2(y.z, y.w);
            *(GAS v2u*)(mix + (rowb + t0 + tok) * DM + 4 * lane) = w; }
    }
    for (int it = tid; it < 32 * 32; it += NWAVES * 64) {
        const int tok = it >> 5, ch = it & 31, t = t0 + tok; const size_t row = rowb + t;
        const bf16* pr = proj + row * NPROJ + ch * 8;
        {
            float cb8[8], cx[3][8];
            unpack8(*(const GAS v4u*)(pr + C_CB), cb8);
#pragma unroll
            for (int k = 0; k < 3; ++k) {
                if (t - k >= 0) { float a8[8], c8[8]; unpack8(*(const GAS v4u*)(pr - (size_t)k * NPROJ + C_CX), a8); unpack8(*(const GAS v4u*)(pr - (size_t)k * NPROJ + C_CC), c8);
#pragma unroll
                    for (int e = 0; e < 8; ++e) cx[k][e] = a8[e] * c8[e];
                } else {
#pragma unroll
                    for (int e = 0; e < 8; ++e) cx[k][e] = 0.f; } }
            const float* cw = F.inp(I_CCW) + (size_t)l * 3 * 256 + ch * 8;
            float o[8];
#pragma unroll
            for (int e = 0; e < 8; ++e) o[e] = cb8[e] * (cw[e] * cx[2][e] + cw[256 + e] * cx[1][e] + cw[512 + e] * cx[0][e]);
            *(GAS v4u*)(mix + row * DM + 512 + ch * 8) = pack8(o);
            if (t >= SEQ - 2) { float* d = F.out + O_CP + ((size_t)(l * NB + b) * 2 + (t - (SEQ - 2))) * 256 + ch * 8;
                *(GAS f32x4*)d = (f32x4){cx[0][0], cx[0][1], cx[0][2], cx[0][3]}; *(GAS f32x4*)(d + 4) = (f32x4){cx[0][4], cx[0][5], cx[0][6], cx[0][7]}; }
        }
        {
            const int w = 2 << (ch >> 3);
            float u0[8], s8[8];
            unpack8(*(const GAS v4u*)(pr + C_DU), u0);
#pragma unroll
            for (int e = 0; e < 8; ++e) s8[e] = u0[e];
            for (int k = 1; k < w; ++k) if (t - k >= 0) { float uk[8]; unpack8(*(const GAS v4u*)(pr - (size_t)k * NPROJ + C_DU), uk);
#pragma unroll
                for (int e = 0; e < 8; ++e) s8[e] += uk[e]; }
            const float cnt = (float)(w < t + 1 ? w : t + 1), ic = 1.0f / cnt;
            float o[8];
#pragma unroll
            for (int e = 0; e < 8; ++e) o[e] = s8[e] * ic - u0[e];
            *(GAS v4u*)(mix + row * DM + 768 + ch * 8) = pack8(o);
            if (t >= SEQ - 15) { float* d = F.out + O_PP + ((size_t)(l * NB + b) * 15 + (t - (SEQ - 15))) * 256 + ch * 8;
                *(GAS f32x4*)d = (f32x4){u0[0], u0[1], u0[2], u0[3]}; *(GAS f32x4*)(d + 4) = (f32x4){u0[4], u0[5], u0[6], u0[7]}; }
        }
        {
            const int h = ch >> 3;
            const float l0 = lse[((size_t)0 * MPAD + row) * 4 + h], l1 = lse[((size_t)1 * MPAD + row) * 4 + h], l2 = lse[((size_t)2 * MPAD + row) * 4 + h];
            const float mx = fmaxf(fmaxf(l0, l1), l2);
            float e0 = __expf(l0 - mx), e1 = __expf(l1 - mx), e2 = __expf(l2 - mx); const float inv = 1.0f / (e0 + e1 + e2);
            e0 *= inv; e1 *= inv; e2 *= inv;
            const float* a0 = atto + ((size_t)0 * MPAD + row) * 256 + ch * 8; const float* a1 = a0 + (size_t)MPAD * 256; const float* a2 = a1 + (size_t)MPAD * 256;
            float o[8];
#pragma unroll
            for (int q4 = 0; q4 < 2; ++q4) { const f32x4 x0 = *(const GAS f32x4*)(a0 + 4 * q4), x1 = *(const GAS f32x4*)(a1 + 4 * q4), x2 = *(const GAS f32x4*)(a2 + 4 * q4);
                const f32x4 y = x0 * e0 + x1 * e1 + x2 * e2; o[4 * q4] = y.x; o[4 * q4 + 1] = y.y; o[4 * q4 + 2] = y.z; o[4 * q4 + 3] = y.w; }
            *(GAS v4u*)(mix + row * DM + 256 + ch * 8) = pack8(o);
        }
    }
    __syncthreads();
}
__device__ __forceinline__ void mixer_sample_row(Frame& F, int l, int b) {
    const bf16* proj = (const bf16*)(F.ws + WS_PROJ); bf16* mix = (bf16*)(F.ws + WS_MIX);
    const float* atto = (const float*)(F.ws + WS_ATTO); const float* lse = (const float*)(F.ws + WS_LSE);
    const int lane = F.lane, c4 = 4 * lane; const size_t row = MP + b;
    const bf16* pr = proj + row * NPROJ + c4;
    auto ld4 = [&](int col, float* f) { const v2u w = *(const GAS v2u*)(pr + col); f[0] = bflo(w.x); f[1] = bfhi(w.x); f[2] = bflo(w.y); f[3] = bfhi(w.y); };
    auto st4 = [&](int col, const float* f) { v2u w; w.x = pk2(f[0], f[1]); w.y = pk2(f[2], f[3]); *(GAS v2u*)(mix + row * DM + col + c4) = w; };
    {
        float a[4], g[4], gn[4]; ld4(C_AV, a); ld4(C_AG, g);
#pragma unroll
        for (int e = 0; e < 4; ++e) gn[e] = a[e] * sigmoidf_(g[e]);
        const float* st = F.inp(I_SA) + ((size_t)(l * 32 + b) * 30) * 256 + c4;
        const float* cw = F.inp(I_CAW) + (size_t)l * 31 * 256 + c4;
        float* so = F.out + O_AS + ((size_t)(l * 32 + b) * 30) * 256 + c4;
        f32x4 acc = *(const GAS f32x4*)(F.inp(I_CAB) + l * 256 + c4);
        for (int jj = 0; jj < 30; ++jj) { const f32x4 sv = *(const GAS f32x4*)(st + jj * 256), wv = *(const GAS f32x4*)(cw + jj * 256); acc += sv * wv; if (jj >= 1) *(GAS f32x4*)(so + (jj - 1) * 256) = sv; }
        const f32x4 wl = *(const GAS f32x4*)(cw + 30 * 256), gv = (f32x4){gn[0], gn[1], gn[2], gn[3]};
        acc += wl * gv; *(GAS f32x4*)(so + 29 * 256) = gv;
        const float mean = wave_sum((acc.x + acc.y) + (acc.z + acc.w)) * (1.f / 256.f);
        const f32x4 d = acc - mean;
        const float var = wave_sum((d.x * d.x + d.y * d.y) + (d.z * d.z + d.w * d.w)) * (1.f / 256.f);
        const float rstd = __builtin_amdgcn_rsqf(var + EPSN);
        const f32x4 g4 = *(const GAS f32x4*)(F.inp(I_LNG) + l * 256 + c4), b4 = *(const GAS f32x4*)(F.inp(I_LNB) + l * 256 + c4);
        f32x4 y = d * rstd * g4 + b4;
        float o[4] = {y.x * sigmoidf_(y.x), y.y * sigmoidf_(y.y), y.z * sigmoidf_(y.z), y.w * sigmoidf_(y.w)};
        st4(0, o);
    }
    {
        float x[4], cb[4], cc[4]; ld4(C_CX, x); ld4(C_CB, cb); ld4(C_CC, cc);
        const float* st = F.inp(I_SC) + ((size_t)(l * 32 + b) * 2) * 256 + c4;
        const float* cw = F.inp(I_CCW) + (size_t)l * 3 * 256 + c4;
        float* so = F.out + O_CS + ((size_t)(l * 32 + b) * 2) * 256 + c4;
        const f32x4 s0 = *(const GAS f32x4*)st, s1 = *(const GAS f32x4*)(st + 256), w0 = *(const GAS f32x4*)cw, w1 = *(const GAS f32x4*)(cw + 256), w2 = *(const GAS f32x4*)(cw + 512);
        const f32x4 cxn = (f32x4){x[0] * cc[0], x[1] * cc[1], x[2] * cc[2], x[3] * cc[3]};
        const f32x4 y = (f32x4){cb[0], cb[1], cb[2], cb[3]} * (w0 * s0 + w1 * s1 + w2 * cxn);
        *(GAS f32x4*)so = s1; *(GAS f32x4*)(so + 256) = cxn;
        float o[4] = {y.x, y.y, y.z, y.w}; st4(512, o);
    }
    {
        float u[4]; ld4(C_DU, u);
        const float* st = F.inp(I_SP) + ((size_t)(l * 32 + b) * 15) * 256 + c4;
        float* so = F.out + O_PS + ((size_t)(l * 32 + b) * 15) * 256 + c4;
        const int w = 2 << (lane >> 4);
        f32x4 s = (f32x4){u[0], u[1], u[2], u[3]};
        for (int jj = 0; jj < 15; ++jj) { const f32x4 sv = *(const GAS f32x4*)(st + jj * 256); if (15 - jj < w) s += sv; if (jj >= 1) *(GAS f32x4*)(so + (jj - 1) * 256) = sv; }
        *(GAS f32x4*)(so + 14 * 256) = (f32x4){u[0], u[1], u[2], u[3]};
        const float iw = 1.0f / (float)w;
        float o[4] = {s.x * iw - u[0], s.y * iw - u[1], s.z * iw - u[2], s.w * iw - u[3]}; st4(768, o);
    }
    {
        const int h = lane >> 4;
        const float l0 = lse[((size_t)0 * MPAD + row) * 4 + h], l1 = lse[((size_t)1 * MPAD + row) * 4 + h], l2 = lse[((size_t)2 * MPAD + row) * 4 + h];
        const float mx = fmaxf(fmaxf(l0, l1), l2);
        float e0 = __expf(l0 - mx), e1 = __expf(l1 - mx), e2 = __expf(l2 - mx); const float inv = 1.0f / (e0 + e1 + e2);
        e0 *= inv; e1 *= inv; e2 *= inv;
        const float* a0 = atto + ((size_t)0 * MPAD + row) * 256 + c4;
        const f32x4 y = *(const GAS f32x4*)a0 * e0 + *(const GAS f32x4*)(a0 + (size_t)MPAD * 256) * e1 + *(const GAS f32x4*)(a0 + (size_t)2 * MPAD * 256) * e2;
        float o[4] = {y.x, y.y, y.z, y.w}; st4(256, o);
    }
}
__device__ __forceinline__ void mixer_phase(Frame F, int l) {
    launder(F); asm volatile("" : "+s"(l));
    for (int tile = F.vcu; tile < NB * 64; tile += F.G) mixer_prompt_tile(F, l, tile);
    const int gw = F.vcu * NWAVES + F.wave, NGW = F.G * NWAVES;
    for (int b = gw; b < MS; b += NGW) mixer_sample_row(F, l, b);
}
__device__ __forceinline__ void final_phase(Frame F) {
    launder(F);
    const float* X = (const float*)(F.ws + WS_X); const float* part = (const float*)(F.ws + WS_PART1);
    const int gw = F.vcu * NWAVES + F.wave, NGW = F.G * NWAVES;
    for (int m = gw; m < MP + MS; m += NGW) {
        const float pv = F.lane < 16 ? part[(size_t)m * 16 + F.lane] : 0.f;
        const float rs = __builtin_amdgcn_rsqf(wave_sum(pv) * (1.0f / 1024.0f) + EPSN);
        float* o = m < MP ? F.out + O_Y + (size_t)m * DM : F.out + O_YS + (size_t)(m - MP) * DM;
#pragma unroll
        for (int j = 0; j < 4; ++j) { const f32x4 v = ((const GAS f32x4*)(X + (size_t)m * DM))[F.lane + 64 * j], g = ((const GAS f32x4*)F.inp(I_FG))[F.lane + 64 * j];
            ((GAS f32x4*)o)[F.lane + 64 * j] = v * rs * g; }
    }
}

template <int NH, int KW>
__device__ __forceinline__ void mini_gemm(const bf16* A, int lda, const bf16* B0, const bf16* B1, int ldb, LAS float* red, int tid, f32x4 (&res)[NH]) {
    const int lane = tid & 63, wave = __builtin_amdgcn_readfirstlane(tid >> 6), c = lane & 31, hh = lane >> 5, k0 = wave * KW;
    constexpr int NBLK = 2 * NH, W = 64 * NH;
    f32x16 acc[NBLK];
#pragma unroll
    for (int nb = 0; nb < NBLK; ++nb)
#pragma unroll
        for (int i = 0; i < 16; ++i) acc[nb][i] = 0.f;
    const bf16* ap = A + (size_t)c * lda + k0 + 8 * hh;
    const bf16* bp[NBLK];
#pragma unroll
    for (int nb = 0; nb < NBLK; ++nb) bp[nb] = (nb < 2 ? B0 + (size_t)(32 * nb + c) * ldb : B1 + (size_t)(32 * (nb - 2) + c) * ldb) + k0 + 8 * hh;
#pragma unroll 2
    for (int s = 0; s < KW / 16; ++s) {
        const bf16x8 a = *(const GAS bf16x8*)(ap + 16 * s);
#pragma unroll
        for (int nb = 0; nb < NBLK; ++nb) { const bf16x8 b = *(const GAS bf16x8*)(bp[nb] + 16 * s); acc[nb] = __builtin_amdgcn_mfma_f32_32x32x16_bf16(a, b, acc[nb], 0, 0, 0); }
    }
#pragma unroll
    for (int nb = 0; nb < NBLK; ++nb)
#pragma unroll
        for (int i = 0; i < 16; ++i) red[(wave * 32 + crow(i, hh)) * W + 32 * nb + c] = acc[nb][i];
    __syncthreads();
    const int row = tid >> 4, c4 = (tid & 15) * 4;
#pragma unroll
    for (int h = 0; h < NH; ++h) { f32x4 v = (f32x4){0.f, 0.f, 0.f, 0.f};
#pragma unroll
        for (int w = 0; w < 8; ++w) v += *(LAS f32x4*)(red + (w * 32 + row) * W + 64 * h + c4);
        res[h] = v; }
    __syncthreads();
}
__device__ __forceinline__ float row_rs16(const float* part, int row) {
    const GAS f32x4* p = (const GAS f32x4*)(part + (size_t)row * 16);
    const f32x4 a = p[0], b = p[1], c = p[2], d = p[3];
    const float s = ((a.x + a.y) + (a.z + a.w)) + ((b.x + b.y) + (b.z + b.w)) + ((c.x + c.y) + (c.z + c.w)) + ((d.x + d.y) + (d.z + d.w));
    return __builtin_amdgcn_rsqf(s * (1.0f / 1024.0f) + EPSN);
}
__device__ __forceinline__ void sample_inproj(const Frame& F, int l) {
    const bf16* wl = (const bf16*)(F.ws + WS_W + (size_t)l * W_LAYER) + W_IN / 2;
    const int row = F.tid >> 4, c4 = (F.tid & 15) * 4;
    for (int j = F.G - 1 - (int)blockIdx.x; j < NPROJ / 64; j += F.G) {
        f32x4 res[1];
        mini_gemm<1, DM / 8>((const bf16*)(F.ws + WS_XB) + (size_t)MP * DM, DM, wl + (size_t)(64 * j) * DM, nullptr, DM, (LAS float*)(F.lds + RING_OFF), F.tid, res);
        const float r = row_rs16((const float*)(F.ws + WS_PART1), MP + row);
        const f32x4 v = res[0] * r; const int col = 64 * j + c4;
        v2u w; w.x = pk2(v.x, v.y); w.y = pk2(v.z, v.w);
        *(GAS v2u*)((bf16*)(F.ws + WS_PROJ) + (size_t)(MP + row) * NPROJ + col) = w;
        if (col >= C_K && col < C_K + 512) {
            float* d = F.out + (col < C_V ? O_KS : O_VS) + (size_t)l * 32 * BUF * 256 + ((size_t)row * BUF + (BUF - 1)) * 256 + (col & 255);
            *(GAS f32x4*)d = v; }
    }
}
template <int KW>
__device__ __forceinline__ void sample_res(const Frame& F, const bf16* A, int lda, const bf16* Bt, const float* base, bf16* xnb, float* part) {
    const int row = F.tid >> 4, c4 = (F.tid & 15) * 4; float* X = (float*)(F.ws + WS_X);
    for (int j = F.G - 1 - (int)blockIdx.x; j < DM / 64; j += F.G) {
        f32x4 res[1];
        mini_gemm<1, KW>(A + (size_t)MP * lda, lda, Bt + (size_t)(64 * j) * lda, nullptr, lda, (LAS float*)(F.lds + RING_OFF), F.tid, res);
        const int col = 64 * j + c4;
        const f32x4 v = res[0] + *(const GAS f32x4*)(base + (size_t)row * DM + col);
        *(GAS f32x4*)(X + (size_t)(MP + row) * DM + col) = v;
        v2u w; w.x = pk2(v.x, v.y); w.y = pk2(v.z, v.w);
        *(GAS v2u*)(xnb + (size_t)(MP + row) * DM + col) = w;
        float ss = (v.x * v.x + v.y * v.y) + (v.z * v.z + v.w * v.w);
        ss += __shfl_xor(ss, 1); ss += __shfl_xor(ss, 2); ss += __shfl_xor(ss, 4); ss += __shfl_xor(ss, 8);
        if ((F.tid & 15) == 0) part[(size_t)(MP + row) * 16 + j] = ss;
    }
}
__device__ __forceinline__ void sample_gateup(const Frame& F, int l) {
    const bf16* wl = (const bf16*)(F.ws + WS_W + (size_t)l * W_LAYER) + W_GU / 2;
    const int row = F.tid >> 4, c4 = (F.tid & 15) * 4;
    for (int j = F.G - 1 - (int)blockIdx.x; j < FFD / 64; j += F.G) {
        f32x4 res[2]; const int pn = j >> 1, half = j & 1;
        mini_gemm<2, DM / 8>((const bf16*)(F.ws + WS_X1B) + (size_t)MP * DM, DM, wl + (size_t)(256 * pn + 64 * half) * DM, wl + (size_t)(256 * pn + 128 + 64 * half) * DM, DM, (LAS float*)(F.lds + RING_OFF), F.tid, res);
        const float r = row_rs16((const float*)(F.ws + WS_PART2), MP + row);
        const f32x4 g = res[0] * r, u = res[1] * r;
        v2u w; w.x = pk2(g.x * sigmoidf_(g.x) * u.x, g.y * sigmoidf_(g.y) * u.y); w.y = pk2(g.z * sigmoidf_(g.z) * u.z, g.w * sigmoidf_(g.w) * u.w);
        *(GAS v2u*)((bf16*)(F.ws + WS_ACT) + (size_t)(MP + row) * FFD + 64 * j + c4) = w;
    }
}

__device__ __forceinline__ void phase_inproj(Frame F, int l) {
    launder(F); asm volatile("" : "+s"(l));
    const bf16* wl = (const bf16*)(F.ws + WS_W + (size_t)l * W_LAYER);
    pg8::Gemm g{(const bf16*)(F.ws + WS_XB), wl + W_IN / 2, MP, NPROJ, DM}; pg8::StaticOrder S; S.init(MP, NPROJ, F.G, (int)blockIdx.x);
    pg8::EpiProj E{(bf16*)(F.ws + WS_PROJ), (const float*)(F.ws + WS_PART1), F.out + O_KP + (size_t)l * MP * 256, F.out + O_VP + (size_t)l * MP * 256, NPROJ};
    pg8::gemm_phase<pg8::EpiProj, pg8::StaticOrder, true, true>(F.lds + RING_OFF, g, S, E, F.tid);
    sample_inproj(F, l);
}
__device__ __forceinline__ void phase_outproj(Frame F, int l) {
    launder(F); asm volatile("" : "+s"(l));
    const bf16* wl = (const bf16*)(F.ws + WS_W + (size_t)l * W_LAYER); float* X = (float*)(F.ws + WS_X);
    pg8::Gemm g{(const bf16*)(F.ws + WS_MIX), wl + W_OUT / 2, MP, DM, DM}; pg8::StaticOrder S; S.init(MP, DM, F.G, (int)blockIdx.x);
    pg8::EpiRes E{l == 0 ? F.inp(I_XP) : X, X, (bf16*)(F.ws + WS_X1B), (float*)(F.ws + WS_PART2)};
    pg8::gemm_phase<pg8::EpiRes, pg8::StaticOrder, true, true>(F.lds + RING_OFF, g, S, E, F.tid);
    sample_res<DM / 8>(F, (const bf16*)(F.ws + WS_MIX), DM, wl + W_OUT / 2, l == 0 ? F.inp(I_XS) : X + (size_t)MP * DM, (bf16*)(F.ws + WS_X1B), (float*)(F.ws + WS_PART2));
}
__device__ __forceinline__ void phase_gateup(Frame F, int l) {
    launder(F); asm volatile("" : "+s"(l));
    const bf16* wl = (const bf16*)(F.ws + WS_W + (size_t)l * W_LAYER);
    pg8::Gemm g{(const bf16*)(F.ws + WS_X1B), wl + W_GU / 2, MP, NGU, DM}; pg8::StaticOrder S; S.init(MP, NGU, F.G, (int)blockIdx.x);
    pg8::EpiSwiGLU E{(bf16*)(F.ws + WS_ACT), (const float*)(F.ws + WS_PART2), FFD};
    pg8::gemm_phase<pg8::EpiSwiGLU, pg8::StaticOrder, true, true>(F.lds + RING_OFF, g, S, E, F.tid);
    sample_gateup(F, l);
}
__device__ __forceinline__ void phase_down(Frame F, int l) {
    launder(F); asm volatile("" : "+s"(l));
    const bf16* wl = (const bf16*)(F.ws + WS_W + (size_t)l * W_LAYER); float* X = (float*)(F.ws + WS_X);
    pg8::Gemm g{(const bf16*)(F.ws + WS_ACT), wl + W_DN / 2, MP, DM, FFD}; pg8::StaticOrder S; S.init(MP, DM, F.G, (int)blockIdx.x);
    pg8::EpiRes E{X, X, (bf16*)(F.ws + WS_XB), (float*)(F.ws + WS_PART1)};
    pg8::gemm_phase<pg8::EpiRes, pg8::StaticOrder, true, true>(F.lds + RING_OFF, g, S, E, F.tid);
    sample_res<FFD / 8>(F, (const bf16*)(F.ws + WS_ACT), FFD, wl + W_DN / 2, X + (size_t)MP * DM, (bf16*)(F.ws + WS_XB), (float*)(F.ws + WS_PART1));
}

__global__ void __launch_bounds__(NWAVES * 64, 2) fwd_megakernel(Args args) {
    extern __shared__ __attribute__((aligned(16))) unsigned char lds[];
    Frame F;
    F.lds = (LAS unsigned char*)lds;
    F.tid = threadIdx.x; F.lane = F.tid & 63; F.wave = __builtin_amdgcn_readfirstlane(F.tid >> 6);
    F.G = gridDim.x; { const int bx = blockIdx.x; F.vcu = (F.G % 8 == 0) ? (bx % 8) * (F.G / 8) + bx / 8 : bx; }
    F.ka = (kaptr_t)__builtin_amdgcn_kernarg_segment_ptr();
    F.out = args.out; F.ws = args.ws;
    for (int u = F.tid; u < (LDS_BYTES - LDSCTL_OFF) / 4; u += NWAVES * 64) ((LAS unsigned*)(F.lds + LDSCTL_OFF))[u] = 0u;
    __syncthreads();
    XcdBarrier bar = xcd_barrier_post((unsigned*)(F.ws + WS_CTL) + CW_BAR, (volatile LAS unsigned*)(F.lds + MISC_OFF) + 8);
#define GRID_BAR() xcd_barrier(bar)

#if !defined(PH) || (PH & 1)
    p0_prologue(F);
#endif
    GRID_BAR();
#if defined(DUP) && (DUP & 1)
    p0_prologue(F); GRID_BAR();
#endif
#pragma unroll 1
    for (int l = 0; l < DEPTH; ++l) {
#if !defined(PH) || (PH & 2)
        phase_inproj(F, l);
#endif
        GRID_BAR();
#if defined(DUP) && (DUP & 2)
        phase_inproj(F, l); GRID_BAR();
#endif
#if !defined(PH) || (PH & 4)
        attn_phase(F, l);
#endif
        GRID_BAR();
#if defined(DUP) && (DUP & 4)
        attn_phase(F, l); GRID_BAR();
#endif
#if !defined(PH) || (PH & 8)
        mixer_phase(F, l);
#endif
        GRID_BAR();
#if defined(DUP) && (DUP & 8)
        mixer_phase(F, l); GRID_BAR();
#endif
#if !defined(PH) || (PH & 16)
        phase_outproj(F, l);
#endif
        GRID_BAR();
#if !defined(PH) || (PH & 32)
        phase_gateup(F, l);
#endif
        GRID_BAR();
#if defined(DUP) && (DUP & 32)
        phase_gateup(F, l); GRID_BAR();
#endif
#if !defined(PH) || (PH & 64)
        phase_down(F, l);
#endif
        GRID_BAR();
    }
#if !defined(PH) || (PH & 128)
    final_phase(F);
#endif
}

extern "C" void kernel_launch(void* const* d_in, const int* in_sizes, int n_in, void* d_out, int out_size, void* d_ws, size_t ws_size, hipStream_t stream) {
    static int grid = 0;
    if (grid == 0) {
        if (n_in != 21 || (size_t)out_size != O_END || ws_size < WS_END) { fprintf(stderr, "kernel_launch: unexpected shapes: n_in %d out %d ws %zu\n", n_in, out_size, ws_size); grid = -1; return; }
        int dev = 0, cus = 0, per_cu = 0;
        if (hipGetDevice(&dev) != hipSuccess || hipDeviceGetAttribute(&cus, hipDeviceAttributeMultiprocessorCount, dev) != hipSuccess) { fprintf(stderr, "kernel_launch: device query failed\n"); grid = -1; return; }
        if (hipFuncSetAttribute((const void*)fwd_megakernel, hipFuncAttributeMaxDynamicSharedMemorySize, LDS_BYTES) != hipSuccess) { fprintf(stderr, "kernel_launch: hipFuncSetAttribute failed\n"); grid = -1; return; }
        if (hipOccupancyMaxActiveBlocksPerMultiprocessor(&per_cu, (const void*)fwd_megakernel, NWAVES * 64, LDS_BYTES) != hipSuccess || per_cu < 1) { fprintf(stderr, "kernel_launch: occupancy query says %d blocks per CU\n", per_cu); grid = -1; (void)hipGetLastError(); return; }
        grid = cus;
    }
    if (grid < 0) return;
    if (hipMemsetAsync((char*)d_ws + WS_CTL, 0, CTL_ZERO_BYTES, stream) != hipSuccess) { fprintf(stderr, "kernel_launch: memset failed\n"); return; }
    Args a{};
    for (int i = 0; i < 21; ++i) a.in[i] = (const float*)d_in[i];
    a.out = (float*)d_out; a.ws = (unsigned char*)d_ws;
    void* kargs[] = {&a};
    hipError_t e = hipLaunchCooperativeKernel((const void*)fwd_megakernel, dim3(grid), dim3(NWAVES * 64), kargs, LDS_BYTES, stream);
    if (e != hipSuccess) fprintf(stderr, "kernel_launch: cooperative launch failed: %s (grid %d)\n", hipGetErrorString(e), grid);
}
```

```cpp
#include <hip/hip_runtime.h>
#include <cstdio>
#include <cstdint>

constexpr int DM = 1024, NPROJ = 2304, FFD = 2816, NGU = 5632, GW = 256;
constexpr int NB = 8, SEQ = 2048, MP = NB * SEQ, MS = 32, MPAD = 16640, DEPTH = 2, BUF = 2048;
constexpr float EPSN = 1e-6f;
constexpr int C_AV = 0, C_AG = 256, C_Q = 512, C_K = 768, C_V = 1024, C_CX = 1280, C_CB = 1536, C_CC = 1792, C_DU = 2048;
constexpr size_t O_Y = 0, O_YS = 16777216, O_KP = 16809984, O_VP = 25198592, O_AP = 33587200, O_CP = 33710080, O_PP = 33718272,
                 O_KS = 33779712, O_VS = 67334144, O_AS = 100888576, O_CS = 101380096, O_PS = 101412864, O_END = 101658624;
namespace pg8 {
#define PG8_LAS __attribute__((address_space(3)))
typedef unsigned short bf16_t;
typedef short bf16x8 __attribute__((ext_vector_type(8)));
typedef float f32x4 __attribute__((ext_vector_type(4)));
typedef unsigned u32x4 __attribute__((ext_vector_type(4)));
constexpr int BM = 256, BK = 64, HALF = 128, HTB = HALF * BK * 2  , STAGE_BYTES = 8 * HTB, NXCD = 8, WGM = 8;

__host__ __device__ __forceinline__ int lds_byte(int r, int c) { const int st = (r >> 4) * 2 + (c >> 5), rr = r & 15, cc = c & 31, ob = rr * 64 + cc * 2; return st * 1024 + (ob ^ (((ob >> 9) & 1) << 5)); }
__host__ __device__ __forceinline__ void stage_rc(int b, int& R, int& C) { const int st = b / 1024, sb = b % 1024, swz = sb ^ (((sb >> 9) & 1) << 5); R = (st >> 1) * 16 + swz / 64; C = (st & 1) * 32 + (swz % 64) / 2; }
__host__ __device__ __forceinline__ int perm32(int rho) { const int n = rho >> 4, i = rho & 15; return 8 * (i >> 2) + 4 * n + (i & 3); }

struct Unit { int pm, pn; };
struct Gemm { const bf16_t* A; const bf16_t* Bt; int M, N, K; };

struct StaticOrder {
    int nM, nN, nwg, G, c;
    __host__ __device__ void init(int M, int N, int G_, int c_) { nM = M / BM; nN = N / BM; nwg = nM * nN; G = G_; c = c_; }
    __host__ __device__ bool next(int i, Unit& u) const {
        const long L = (long)i * G + c; if (L >= nwg) return false;
        int wgid = (int)L; { const int q = nwg / NXCD, r = nwg % NXCD, xcd = wgid % NXCD, off = wgid / NXCD; wgid = (xcd < r ? xcd * (q + 1) : r * (q + 1) + (xcd - r) * q) + off; }
        const int nig = WGM * nN, gid = wgid / nig, fm = gid * WGM, gsz = (nM - fm) < WGM ? (nM - fm) : WGM;
        u.pm = fm + ((wgid % nig) % gsz); u.pn = (wgid % nig) / gsz; return true;
    }
    __device__ __forceinline__ void a_ready(const Unit&) const {}
    __device__ __forceinline__ void done(const Unit&) const {}
};
__device__ __forceinline__ unsigned cvt_pk_bf16(float lo, float hi) { unsigned r; asm volatile("v_cvt_pk_bf16_f32 %0, %1, %2" : "=v"(r) : "v"(lo), "v"(hi)); return r; }
typedef float f32x2 __attribute__((ext_vector_type(2)));
__device__ __forceinline__ float row_rs(const float* part, int row, int fq) {
    const f32x4 p = *(const f32x4*)(part + (size_t)row * 16 + 4 * fq);
    float s = (p[0] + p[1]) + (p[2] + p[3]);
    s += __shfl_xor(s, 16); s += __shfl_xor(s, 32);
    return __builtin_amdgcn_rsqf(s * (1.0f / 1024.0f) + 1e-6f);
}
struct EpiProj {
    static constexpr bool PERM = true, AFTER_DRAIN = false;
    bf16_t* proj; const float* part; float* kp; float* vp; int ldp;
    __device__ __forceinline__ void operator()(const f32x4 (&acc)[2][2][4][2], const Unit& u, int wr, int wc, int fr, int fq) const {
        const int row0 = u.pm * BM + wr * 64 + fr, cw = wc * 32 + 8 * fq;
        const bool iskv = (u.pn == 3) || (u.pn == 4);
        float* kvp = (u.pn == 3) ? kp : vp;
#pragma unroll
        for (int ai = 0; ai < 2; ++ai)
#pragma unroll
            for (int m = 0; m < 4; ++m) {
                const int row = row0 + ai * HALF + m * 16;
                const float r = row_rs(part, row, fq);
                bf16_t* rowp = proj + (size_t)row * ldp + u.pn * BM + cw;
#pragma unroll
                for (int bj = 0; bj < 2; ++bj) {
                    const f32x4 v0 = acc[ai][bj][m][0] * r, v1 = acc[ai][bj][m][1] * r;
                    u32x4 w; w.x = cvt_pk_bf16(v0[0], v0[1]); w.y = cvt_pk_bf16(v0[2], v0[3]); w.z = cvt_pk_bf16(v1[0], v1[1]); w.w = cvt_pk_bf16(v1[2], v1[3]);
                    *(u32x4*)(rowp + bj * HALF) = w;
                    if (iskv) {
                        const int c = bj * HALF + cw;
                        float* d = kvp + (size_t)row * 256 + c; *(f32x4*)d = v0; *(f32x4*)(d + 4) = v1;
                    }
                }
            }
    }
};
struct EpiRes {
    static constexpr bool PERM = true, AFTER_DRAIN = false;
    const bf16_t* base; bf16_t* xo; float* part;
    __device__ __forceinline__ void operator()(const f32x4 (&acc)[2][2][4][2], const Unit& u, int wr, int wc, int fr, int fq) const {
        const int row0 = u.pm * BM + wr * 64 + fr, colt = u.pn * BM + wc * 32 + 8 * fq;
#pragma unroll
        for (int ai = 0; ai < 2; ++ai)
#pragma unroll
            for (int m = 0; m < 4; ++m) {
                const int row = row0 + ai * HALF + m * 16;
                float ss = 0.f;
#pragma unroll
                for (int bj = 0; bj < 2; ++bj) {
                    const size_t off = (size_t)row * 1024 + colt + bj * HALF;
                    const u32x4 b = *(const u32x4*)(base + off);
                    f32x4 v0 = acc[ai][bj][m][0], v1 = acc[ai][bj][m][1];
                    v0[0] += __builtin_bit_cast(float, b.x << 16); v0[1] += __builtin_bit_cast(float, b.x & 0xffff0000u); v0[2] += __builtin_bit_cast(float, b.y << 16); v0[3] += __builtin_bit_cast(float, b.y & 0xffff0000u);
                    v1[0] += __builtin_bit_cast(float, b.z << 16); v1[1] += __builtin_bit_cast(float, b.z & 0xffff0000u); v1[2] += __builtin_bit_cast(float, b.w << 16); v1[3] += __builtin_bit_cast(float, b.w & 0xffff0000u);
                    u32x4 w; w.x = cvt_pk_bf16(v0[0], v0[1]); w.y = cvt_pk_bf16(v0[2], v0[3]); w.z = cvt_pk_bf16(v1[0], v1[1]); w.w = cvt_pk_bf16(v1[2], v1[3]);
                    *(u32x4*)(xo + off) = w;
                    ss += (v0[0] * v0[0] + v0[1] * v0[1]) + (v0[2] * v0[2] + v0[3] * v0[3]) + (v1[0] * v1[0] + v1[1] * v1[1]) + (v1[2] * v1[2] + v1[3] * v1[3]);
                }
                ss += __shfl_xor(ss, 16); ss += __shfl_xor(ss, 32);
                if (fq == 0) part[(size_t)row * 16 + u.pn * 4 + wc] = ss;
            }
    }
};
template <int MODE = 0> struct EpiSwiGLU_ {
    static constexpr bool PERM = true, AFTER_DRAIN = false;
    bf16_t* act; const float* part; int lda;
    __device__ __forceinline__ void operator()(const f32x4 (&acc)[2][2][4][2], const Unit& u, int wr, int wc, int fr, int fq) const {
        const int row0 = u.pm * BM + wr * 64 + fr, colt = u.pn * HALF + wc * 32 + 8 * fq;
#pragma unroll
        for (int ai = 0; ai < 2; ++ai)
#pragma unroll
            for (int m = 0; m < 4; ++m) {
                const int row = row0 + ai * HALF + m * 16;
                const float r = row_rs(part, row, fq);
                float o[8];
#pragma unroll
                for (int n = 0; n < 2; ++n)
#pragma unroll
                    for (int j = 0; j < 4; ++j) {
                        const float g = acc[ai][0][m][n][j] * r, uu = acc[ai][1][m][n][j] * r;
                        o[4 * n + j] = g * __builtin_amdgcn_rcpf(1.0f + __expf(-g)) * uu;
                    }
                u32x4 w; w.x = cvt_pk_bf16(o[0], o[1]); w.y = cvt_pk_bf16(o[2], o[3]); w.z = cvt_pk_bf16(o[4], o[5]); w.w = cvt_pk_bf16(o[6], o[7]);
                if (MODE == 0) *(u32x4*)(act + (size_t)row * lda + colt) = w;
                else if (MODE == 1) asm volatile("" :: "v"(w.x), "v"(w.y), "v"(w.z), "v"(w.w));
                else *(u32x4*)(act + (size_t)(row & 255) * lda + (colt & 127)) = w;
            }
    }
};
typedef EpiSwiGLU_<0> EpiSwiGLU;

template <class Epi, class Sched, bool ALIGN_EPI = false, bool SP2 = false>
__device__ __forceinline__ void gemm_phase(PG8_LAS unsigned char* lds, const Gemm g, const Sched& S, const Epi& E, const int tid) {
    const int wid = __builtin_amdgcn_readfirstlane(tid >> 6), lane = tid & 63, wr = wid >> 2, wc = wid & 3, fr = lane & 15, fq = lane >> 4;
    const int K = g.K, nt = K / BK;
    unsigned voffA[2], voffB[2];
#pragma unroll
    for (int i = 0; i < 2; ++i) { int R, C; stage_rc(tid * 16 + i * 8192, R, C); const int Rb = Epi::PERM ? ((R & ~31) + perm32(R & 31)) : R;
        voffA[i] = (unsigned)(R * K + C) * 2u; voffB[i] = (unsigned)(Rb * K + C) * 2u; }
    const size_t kstep = (size_t)(BK * 2);
    const size_t hstep = (size_t)HALF * K * 2;
    const size_t tstep = 2 * hstep;
    const unsigned ldsw = (unsigned)wid * 1024u;
    const int aoff = lds_byte(wr * 64 + fr, fq * 8), boff = lds_byte(wc * 32 + fr, fq * 8);
#define PG8_SA(b, h) (((b) * 2 + (h)) * HTB)
#define PG8_SB(b, h) ((4 + (b) * 2 + (h)) * HTB)
#define PG8_STAGE(bufoff, gbase, voff) do { _Pragma("unroll") for (int _i = 0; _i < 2; ++_i) \
        __builtin_amdgcn_global_load_lds((const unsigned*)((const char*)(gbase) + (voff)[_i]), (PG8_LAS unsigned*)(lds + (bufoff) + ldsw + _i * 8192), 16, 0, 0); } while (0)
#define PG8_LDA(dst, b, h) do { _Pragma("unroll") for (int m = 0; m < 4; ++m) _Pragma("unroll") for (int k = 0; k < 2; ++k) dst[m][k] = *(const PG8_LAS bf16x8*)(lds + PG8_SA(b, h) + aoff + m * 2048 + k * 1024); } while (0)
#define PG8_LDB(dst, b, h) do { _Pragma("unroll") for (int n = 0; n < 2; ++n) _Pragma("unroll") for (int k = 0; k < 2; ++k) dst[n][k] = *(const PG8_LAS bf16x8*)(lds + PG8_SB(b, h) + boff + n * 2048 + k * 1024); } while (0)
#define PG8_MMA(ai, bj, At, Bt) do { __builtin_amdgcn_s_setprio(1); _Pragma("unroll") for (int m = 0; m < 4; ++m) _Pragma("unroll") for (int n = 0; n < 2; ++n) _Pragma("unroll") for (int k = 0; k < 2; ++k) \
        acc[ai][bj][m][n] = __builtin_amdgcn_mfma_f32_16x16x32_bf16(Bt[n][k], At[m][k], acc[ai][bj][m][n], 0, 0, 0); __builtin_amdgcn_s_setprio(0); } while (0)
#define PG8_WAIT_V(n) asm volatile("s_waitcnt vmcnt(" #n ")" ::: "memory")
#define PG8_WAIT_L(n) asm volatile("s_waitcnt lgkmcnt(" #n ")" ::: "memory")
#define PG8_BAR __builtin_amdgcn_s_barrier()
#define PG8_SCHED __builtin_amdgcn_sched_barrier(0)
    Unit cur, nxt; int ui = 0;
    if (!S.next(0, cur)) return;
    f32x4 acc[2][2][4][2];
#pragma unroll
    for (int a = 0; a < 2; ++a)
#pragma unroll
        for (int b = 0; b < 2; ++b)
#pragma unroll
            for (int m = 0; m < 4; ++m)
#pragma unroll
                for (int n = 0; n < 2; ++n) acc[a][b][m][n] = (f32x4){0.f, 0.f, 0.f, 0.f};
    bf16x8 At[4][2], B0[2][2], B1[2][2];
    const char* cA = (const char*)g.A + (size_t)cur.pm * tstep; const char* cB = (const char*)g.Bt + (size_t)cur.pn * tstep;
    S.a_ready(cur);
    if constexpr (SP2) {
        PG8_STAGE(PG8_SB(0, 0), cB, voffB); PG8_STAGE(PG8_SB(0, 1), cB + hstep, voffB); PG8_STAGE(PG8_SA(0, 0), cA, voffA); PG8_STAGE(PG8_SA(0, 1), cA + hstep, voffA);
        if (wr == 1) PG8_BAR;
        PG8_WAIT_V(2); PG8_BAR;
        PG8_STAGE(PG8_SB(1, 0), cB + kstep, voffB); PG8_STAGE(PG8_SA(1, 0), cA + kstep, voffA); PG8_STAGE(PG8_SB(1, 1), cB + hstep + kstep, voffB);
        PG8_WAIT_V(6); PG8_BAR;
    } else {
        PG8_STAGE(PG8_SB(0, 0), cB, voffB); PG8_STAGE(PG8_SA(0, 0), cA, voffA); PG8_STAGE(PG8_SB(0, 1), cB + hstep, voffB); PG8_STAGE(PG8_SA(0, 1), cA + hstep, voffA);
        if (wr == 1) PG8_BAR;
        PG8_WAIT_V(4); PG8_BAR;
        PG8_STAGE(PG8_SB(1, 0), cB + kstep, voffB); PG8_STAGE(PG8_SA(1, 0), cA + kstep, voffA); PG8_STAGE(PG8_SB(1, 1), cB + hstep + kstep, voffB);
        PG8_WAIT_V(6); PG8_BAR;
    }
    for (;;) {
        const bool has_next = S.next(ui + 1, nxt);
        const char* nA = has_next ? (const char*)g.A + (size_t)nxt.pm * tstep : cA; const char* nB = has_next ? (const char*)g.Bt + (size_t)nxt.pn * tstep : cB;
        for (int t = 0; t < nt; t += 2) {
            const bool last = (t == nt - 2);
            const char* a1 = cA + (size_t)(t + 1) * kstep;
            const char* a2 = last ? nA : cA + (size_t)(t + 2) * kstep; const char* b2 = last ? nB : cB + (size_t)(t + 2) * kstep;
            const char* a3 = a2 + kstep; const char* b3 = b2 + kstep;
            if (last && has_next) S.a_ready(nxt);
            if constexpr (SP2) {
            PG8_LDB(B0, 0, 0); PG8_LDB(B1, 0, 1); PG8_SCHED; PG8_LDA(At, 0, 0); PG8_STAGE(PG8_SA(1, 1), a1 + hstep, voffA);
            PG8_WAIT_V(8); PG8_WAIT_L(0); PG8_BAR; PG8_MMA(0, 0, At, B0); PG8_MMA(0, 1, At, B1); PG8_BAR; PG8_SCHED;
            PG8_LDA(At, 0, 1); PG8_STAGE(PG8_SB(0, 0), b2, voffB); PG8_STAGE(PG8_SB(0, 1), b2 + hstep, voffB); PG8_STAGE(PG8_SA(0, 0), a2, voffA);
            PG8_WAIT_V(8); PG8_WAIT_L(0); PG8_BAR; PG8_MMA(1, 0, At, B0); PG8_MMA(1, 1, At, B1); PG8_BAR; PG8_SCHED;
            PG8_LDB(B0, 1, 0); PG8_LDB(B1, 1, 1); PG8_SCHED; PG8_LDA(At, 1, 0); PG8_STAGE(PG8_SA(0, 1), a2 + hstep, voffA);
            PG8_WAIT_V(8); PG8_WAIT_L(0); PG8_BAR; PG8_MMA(0, 0, At, B0); PG8_MMA(0, 1, At, B1); PG8_BAR; PG8_SCHED;
            PG8_LDA(At, 1, 1); PG8_STAGE(PG8_SB(1, 0), b3, voffB); PG8_STAGE(PG8_SB(1, 1), b3 + hstep, voffB); PG8_STAGE(PG8_SA(1, 0), a3, voffA);
            PG8_WAIT_V(8); PG8_WAIT_L(0); PG8_BAR; PG8_MMA(1, 0, At, B0); PG8_MMA(1, 1, At, B1); PG8_BAR; PG8_SCHED;
            } else {
            PG8_LDB(B0, 0, 0); PG8_SCHED; PG8_LDA(At, 0, 0); PG8_STAGE(PG8_SA(1, 1), a1 + hstep, voffA);
            PG8_WAIT_L(8); PG8_BAR; PG8_WAIT_L(0); PG8_MMA(0, 0, At, B0); PG8_BAR; PG8_SCHED;
            PG8_LDB(B1, 0, 1); PG8_STAGE(PG8_SB(0, 0), b2, voffB);
            PG8_BAR; PG8_WAIT_L(0); PG8_MMA(0, 1, At, B1); PG8_BAR;
            PG8_LDA(At, 0, 1); PG8_STAGE(PG8_SA(0, 0), a2, voffA);
            PG8_BAR; PG8_WAIT_L(0); PG8_MMA(1, 0, At, B0); PG8_BAR; PG8_SCHED;
            PG8_STAGE(PG8_SB(0, 1), b2 + hstep, voffB);
            PG8_WAIT_V(6); PG8_BAR; PG8_MMA(1, 1, At, B1); PG8_BAR;
            PG8_LDB(B0, 1, 0); PG8_SCHED; PG8_LDA(At, 1, 0); PG8_STAGE(PG8_SA(0, 1), a2 + hstep, voffA);
            PG8_WAIT_L(8); PG8_BAR; PG8_WAIT_L(0); PG8_MMA(0, 0, At, B0); PG8_BAR; PG8_SCHED;
            PG8_LDB(B1, 1, 1); PG8_STAGE(PG8_SB(1, 0), b3, voffB);
            PG8_BAR; PG8_WAIT_L(0); PG8_MMA(0, 1, At, B1); PG8_BAR;
            PG8_LDA(At, 1, 1); PG8_STAGE(PG8_SA(1, 0), a3, voffA);
            PG8_BAR; PG8_WAIT_L(0); PG8_MMA(1, 0, At, B0); PG8_BAR; PG8_SCHED;
            PG8_STAGE(PG8_SB(1, 1), b3 + hstep, voffB);
            PG8_WAIT_V(6); PG8_BAR; PG8_MMA(1, 1, At, B1); PG8_BAR;
            }
        }
        if constexpr (ALIGN_EPI) { if (wr == 0) PG8_BAR; }
        if constexpr (!Epi::AFTER_DRAIN) { E(acc, cur, wr, wc, fr, fq); S.done(cur); }
        if (!has_next) break;
#pragma unroll
        for (int a = 0; a < 2; ++a)
#pragma unroll
            for (int b = 0; b < 2; ++b)
#pragma unroll
                for (int m = 0; m < 4; ++m)
#pragma unroll
                    for (int n = 0; n < 2; ++n) acc[a][b][m][n] = (f32x4){0.f, 0.f, 0.f, 0.f};
        cur = nxt; cA = nA; cB = nB; ++ui;
        if constexpr (ALIGN_EPI) { if (wr == 1) PG8_BAR; }
    }
    PG8_WAIT_V(0);
    if constexpr (!ALIGN_EPI) { if (wr == 0) PG8_BAR; }
    PG8_BAR;
    if constexpr (Epi::AFTER_DRAIN) { E.fused(acc, cur, wr, wc, fr, fq, lds, wid, lane); S.done(cur); }
#undef PG8_SA
#undef PG8_SB
#undef PG8_STAGE
#undef PG8_LDA
#undef PG8_LDB
#undef PG8_MMA
#undef PG8_WAIT_V
#undef PG8_WAIT_L
#undef PG8_BAR
#undef PG8_SCHED
}
}

constexpr int NWAVES = 8;
constexpr size_t MiB = 1u << 20;
constexpr size_t WS_CTL = 0, CTL_ZERO_BYTES = 1 * MiB;
constexpr size_t WS_PART1 = 1 * MiB, WS_PART2 = 3 * MiB, WS_LSE = 5 * MiB;
constexpr size_t WS_W = 8 * MiB;
constexpr size_t W_IN = 0, W_OUT = (size_t)NPROJ * DM * 2, W_GU = W_OUT + (size_t)DM * DM * 2, W_DN = W_GU + (size_t)NGU * DM * 2, W_LAYER = W_DN + (size_t)DM * FFD * 2;
static_assert(W_LAYER == 23 * MiB, "weights per layer");
constexpr size_t WS_XB = 56 * MiB, WS_X1B = 89 * MiB, WS_MIX = 122 * MiB;
constexpr size_t WS_X = 155 * MiB;
constexpr size_t WS_PROJ = 220 * MiB;
constexpr size_t WS_ATTO = 294 * MiB;
constexpr size_t WS_ACT = 220 * MiB;
constexpr size_t WS_END = 344 * MiB;
static_assert(WS_PROJ + (size_t)MPAD * NPROJ * 2 <= WS_ATTO && WS_ATTO + (size_t)3 * MPAD * 256 * 4 <= WS_END && WS_ACT + (size_t)MPAD * FFD * 2 <= WS_END, "ws map");
static_assert(WS_X + (size_t)MPAD * DM * 4 <= WS_PROJ && WS_MIX + (size_t)MPAD * DM * 2 <= WS_X && WS_W + 2 * W_LAYER <= WS_XB, "ws map 2");
constexpr int CW_BAR = 4096;

constexpr int RING_OFF = 0, RING_BYTES = 131072;
constexpr int LDSCTL_OFF = RING_BYTES, MISC_OFF = LDSCTL_OFF + 320;
constexpr int LDS_BYTES = 147456;

#define GAS __attribute__((address_space(1)))
#define LAS __attribute__((address_space(3)))
typedef unsigned short bf16;
typedef unsigned v4u __attribute__((ext_vector_type(4)));
typedef unsigned v2u __attribute__((ext_vector_type(2)));
typedef float f32x4 __attribute__((ext_vector_type(4)));
typedef float f32x16 __attribute__((ext_vector_type(16)));
typedef short bf16x8 __attribute__((ext_vector_type(8)));
typedef short s16x4 __attribute__((ext_vector_type(4)));
typedef GAS unsigned gu32;
#define LDS_WAIT() asm volatile("s_waitcnt lgkmcnt(0)" ::: "memory")
#define VM_WAIT() asm volatile("s_waitcnt vmcnt(0)" ::: "memory")
__device__ __forceinline__ unsigned f2bf(float f) { unsigned u = __builtin_bit_cast(unsigned, f); return (u + 0x7fffu + ((u >> 16) & 1u)) >> 16; }
__device__ __forceinline__ unsigned pk2(float lo, float hi) { return pg8::cvt_pk_bf16(lo, hi); }
__device__ __forceinline__ float bflo(unsigned w) { return __builtin_bit_cast(float, w << 16); }
__device__ __forceinline__ float bfhi(unsigned w) { return __builtin_bit_cast(float, w & 0xffff0000u); }
__device__ __forceinline__ void unpack8(const v4u w, float* f) { f[0] = bflo(w.x); f[1] = bfhi(w.x); f[2] = bflo(w.y); f[3] = bfhi(w.y); f[4] = bflo(w.z); f[5] = bfhi(w.z); f[6] = bflo(w.w); f[7] = bfhi(w.w); }
__device__ __forceinline__ v4u pack8(const float* f) { v4u w; w.x = pk2(f[0], f[1]); w.y = pk2(f[2], f[3]); w.z = pk2(f[4], f[5]); w.w = pk2(f[6], f[7]); return w; }
__device__ __forceinline__ float sigmoidf_(float x) { return __builtin_amdgcn_rcpf(1.0f + __expf(-x)); }
__device__ __forceinline__ float wave_sum(float v) {
#pragma unroll
    for (int o = 1; o < 64; o <<= 1) v += __shfl_xor(v, o);
    return v;
}
__device__ __forceinline__ float wave_max(float v) {
#pragma unroll
    for (int o = 1; o < 64; o <<= 1) v = fmaxf(v, __shfl_xor(v, o));
    return v;
}

#define XB_TMO      128
#define XB_XCNT(j)  (256  + 64 * (j))
#define XB_XSUB(j)  (1280 + 64 * (j))
#define XB_XGEN(j)  (2304 + 64 * (j))
#define XB_TOP      3328
#define XB_TOPGEN   3392
#define XCD_BAR_WORDS 3456
#define XB_SPIN_CAP (1u << 18)

__device__ __forceinline__ unsigned xb_ld(unsigned* p)              { return __hip_atomic_load(p, __ATOMIC_RELAXED, __HIP_MEMORY_SCOPE_AGENT); }
__device__ __forceinline__ unsigned xb_add(unsigned* p, unsigned v) { return __hip_atomic_fetch_add(p, v, __ATOMIC_RELAXED, __HIP_MEMORY_SCOPE_AGENT); }
__device__ __forceinline__ unsigned xb_xcc_id() { return (unsigned)__builtin_amdgcn_s_getreg((3 << 11) | 20) & 0xFu; }
#define XB_SPIN(cond, bar) do { unsigned _sp = 0; while (cond) { __builtin_amdgcn_s_sleep(1); \
    if ((++_sp & 255u) == 0u) { if (xb_ld(&(bar)[XB_TMO])) break; if (_sp > XB_SPIN_CAP) { atomicAdd(&(bar)[XB_TMO], 1u); break; } } } } while (0)

struct XcdBarrier {
    unsigned* bar; unsigned x;
    volatile LAS unsigned* st;
};
__device__ __forceinline__ XcdBarrier xcd_barrier_post(unsigned* bar, volatile LAS unsigned* st) {
    XcdBarrier b; b.bar = bar; b.x = xb_xcc_id(); b.st = st;
    if (threadIdx.x == 0) (void)xb_add(&bar[XB_XCNT(b.x)], 1u);
    return b;
}
__device__ __forceinline__ void xcd_barrier_complete(unsigned* bar, unsigned x, unsigned& nloc, unsigned& nx) {
    const unsigned G = gridDim.x * gridDim.y * gridDim.z;
    unsigned sum, cnt, mine, sp = 0u;
    for (;;) {
        sum = 0u; cnt = 0u; mine = 0u;
#pragma unroll
        for (unsigned j = 0; j < 16; ++j) { const unsigned c = xb_ld(&bar[XB_XCNT(j)]); sum += c; cnt += (c > 0u) ? 1u : 0u; mine = (j == x) ? c : mine; }
        if (sum == G) break;
        __builtin_amdgcn_s_sleep(1);
        if ((++sp & 255u) == 0u) { if (xb_ld(&bar[XB_TMO])) break; if (sp > XB_SPIN_CAP) { atomicAdd(&bar[XB_TMO], 1u); break; } }
    }
    nloc = mine > 0u ? mine : 1u; nx = cnt > 0u ? cnt : 1u;
}
__device__ __forceinline__ void xcd_barrier(const XcdBarrier& b) {
    asm volatile("s_waitcnt vmcnt(0)" ::: "memory");
    __syncthreads();
    if (threadIdx.x == 0) {
        unsigned* bar = b.bar;
        __builtin_amdgcn_s_waitcnt(0);
        unsigned nloc = b.st[0], nx = b.st[1];
        if (nloc == 0u) { xcd_barrier_complete(bar, b.x, nloc, nx); b.st[0] = nloc; b.st[1] = nx; }
        const unsigned old = xb_add(&bar[XB_XSUB(b.x)], 1u);
        const unsigned gen = old / nloc;
        if (old + 1u == (gen + 1u) * nloc) {
            __builtin_amdgcn_fence(__ATOMIC_RELEASE, "agent");
            asm volatile("s_waitcnt vmcnt(0)" ::: "memory");
            const unsigned og = xb_add(&bar[XB_TOP], 1u);
            const unsigned tg = og / nx;
            if (og + 1u == (tg + 1u) * nx) xb_add(&bar[XB_TOPGEN], 1u);
            else XB_SPIN(xb_ld(&bar[XB_TOPGEN]) == tg, bar);
            __builtin_amdgcn_fence(__ATOMIC_ACQUIRE, "agent");
            xb_add(&bar[XB_XGEN(b.x)], 1u);
            asm volatile("s_waitcnt vmcnt(0)" ::: "memory");
        } else {
            XB_SPIN(xb_ld(&bar[XB_XGEN(b.x)]) == gen, bar);
            __builtin_amdgcn_fence(__ATOMIC_ACQUIRE, "agent");
            asm volatile("s_waitcnt vmcnt(0)" ::: "memory");
        }
    }
    __syncthreads();
}

struct Args { const float* in[21]; float* out; unsigned char* ws; };
typedef __attribute__((address_space(4))) const unsigned char* kaptr_t;
struct Frame {
    LAS unsigned char* lds;
    int tid, lane, wave, G, vcu;
    kaptr_t ka;
    float* out; unsigned char* ws;
    __device__ __forceinline__ const float* inp(int i) const { return *(const float* const __attribute__((address_space(4)))*)(ka + 8 * i); }
};
__device__ __forceinline__ void launder(Frame& F) {
    asm volatile("" : "+s"(F.ka), "+s"(F.G), "+s"(F.vcu), "+v"(F.tid));
    F.lane = F.tid & 63; F.wave = __builtin_amdgcn_readfirstlane(F.tid >> 6);
    F.out = *(float* const __attribute__((address_space(4)))*)(F.ka + 8 * 21);
    F.ws = *(unsigned char* const __attribute__((address_space(4)))*)(F.ka + 8 * 22);
}
enum { I_XP = 0, I_XS, I_CK, I_CV, I_SA, I_SC, I_SP, I_WIN, I_CAW, I_CAB, I_LNG, I_LNB, I_CCW, I_PW, I_PS, I_WOUT, I_N1, I_N2, I_WGU, I_WDN, I_FG };

__device__ __forceinline__ void tr_item(const float* W, int ldw, int k0, int srccol0, const float* ksc, bf16* WT, int K, int dstrow0, LAS float* scr, int lane) {
#pragma unroll 8
    for (int i = 0; i < 32; ++i) { const int kk = 2 * i + (lane >> 5); float v = W[(size_t)(k0 + kk) * ldw + srccol0 + (lane & 31)]; if (ksc) v *= ksc[k0 + kk]; scr[kk * 33 + (lane & 31)] = v; }
    LDS_WAIT(); asm volatile("" ::: "memory");
    const int c = lane & 7;
#pragma unroll
    for (int j = 0; j < 4; ++j) { const int n = (lane >> 3) + 8 * j; const LAS float* s = scr + (8 * c) * 33 + n;
        v4u o; o.x = pk2(s[0 * 33], s[1 * 33]); o.y = pk2(s[2 * 33], s[3 * 33]); o.z = pk2(s[4 * 33], s[5 * 33]); o.w = pk2(s[6 * 33], s[7 * 33]);
        *(GAS v4u*)(WT + (size_t)(dstrow0 + n) * K + k0 + 8 * c) = o; }
    LDS_WAIT(); asm volatile("" ::: "memory");
}
__device__ __forceinline__ void pool_fold_item(const float* wout, const float* pw, const float* ps, bf16* WT, int g, int n0, LAS float* scr, int lane) {
#pragma unroll 8
    for (int i = 0; i < 32; ++i) { const int e = 2 * i + (lane >> 5); scr[e * 33 + (lane & 31)] = wout[(size_t)(768 + g * 64 + e) * DM + n0 + (lane & 31)] * ps[g * 64 + e]; }
    LDS_WAIT(); asm volatile("" ::: "memory");
    const int n = lane & 31, half = lane >> 5;
    for (int cb = 0; cb < 4; ++cb) {
        float o[8];
#pragma unroll
        for (int i = 0; i < 8; ++i) o[i] = 0.f;
        const float* pwr = pw + (size_t)(g * 64 + half * 32 + cb * 8) * 64;
        for (int e = 0; e < 64; ++e) { const float s = scr[e * 33 + n];
#pragma unroll
            for (int i = 0; i < 8; ++i) o[i] += pwr[i * 64 + e] * s; }
        *(GAS v4u*)(WT + (size_t)(n0 + n) * DM + 768 + g * 64 + half * 32 + cb * 8) = pack8(o);
    }
    LDS_WAIT(); asm volatile("" ::: "memory");
}
__device__ __forceinline__ void p0_prologue(Frame F) {
    launder(F);
    LAS float* scr = (LAS float*)(F.lds + RING_OFF + F.wave * 16384);
    const int gw = F.vcu * NWAVES + F.wave, NGW = F.G * NWAVES;
    constexpr int I_IN = 16 * 72, I_OUTP = 12 * 32, I_OUTF = 4 * 32, I_GU = 16 * 176, I_DN = 44 * 32, I_L = I_IN + I_OUTP + I_OUTF + I_GU + I_DN;
    for (int it = gw; it < 2 * I_L; it += NGW) {
        const int l = it / I_L; int r = it % I_L;
        bf16* wl = (bf16*)(F.ws + WS_W + (size_t)l * W_LAYER);
        if (r < I_IN) { const int kb = r / 72, nb = r % 72; tr_item(F.inp(I_WIN) + (size_t)l * DM * NPROJ, NPROJ, 64 * kb, 32 * nb, F.inp(I_N1) + l * DM, wl + W_IN / 2, DM, 32 * nb, scr, F.lane); continue; } r -= I_IN;
        if (r < I_OUTP) { const int kb = r / 32, nb = r % 32; tr_item(F.inp(I_WOUT) + (size_t)l * DM * DM, DM, 64 * kb, 32 * nb, nullptr, wl + W_OUT / 2, DM, 32 * nb, scr, F.lane); continue; } r -= I_OUTP;
        if (r < I_OUTF) { const int g = r / 32, nb = r % 32; pool_fold_item(F.inp(I_WOUT) + (size_t)l * DM * DM, F.inp(I_PW) + (size_t)l * 4 * 64 * 64, F.inp(I_PS) + l * GW, wl + W_OUT / 2, g, 32 * nb, scr, F.lane); continue; } r -= I_OUTF;
        if (r < I_GU) { const int kb = r / 176, nb = r % 176; const int R = 32 * nb, pn = R >> 8, bj = (R >> 7) & 1, j0 = R & 127;
            tr_item(F.inp(I_WGU) + (size_t)l * DM * NGU, NGU, 64 * kb, bj * FFD + 128 * pn + j0, F.inp(I_N2) + l * DM, wl + W_GU / 2, DM, R, scr, F.lane); continue; } r -= I_GU;
        { const int kb = r / 32, nb = r % 32; tr_item(F.inp(I_WDN) + (size_t)l * FFD * DM, DM, 64 * kb, 32 * nb, nullptr, wl + W_DN / 2, FFD, 32 * nb, scr, F.lane); }
    }
    bf16* xb = (bf16*)(F.ws + WS_XB); float* part1 = (float*)(F.ws + WS_PART1);
    for (int m = gw; m < MPAD; m += NGW) {
        const float* src = m < MP ? F.inp(I_XP) + (size_t)m * DM : (m < MP + MS ? F.inp(I_XS) + (size_t)(m - MP) * DM : nullptr);
        f32x4 v[4]; float s = 0.f;
#pragma unroll
        for (int j = 0; j < 4; ++j) { v[j] = src ? ((const GAS f32x4*)src)[F.lane + 64 * j] : (f32x4){0.f, 0.f, 0.f, 0.f}; s += (v[j].x * v[j].x + v[j].y * v[j].y) + (v[j].z * v[j].z + v[j].w * v[j].w); }
        s = wave_sum(s);
        GAS v2u* o8 = (GAS v2u*)(xb + (size_t)m * DM) + F.lane;
#pragma unroll
        for (int j = 0; j < 4; ++j) { v2u w; w.x = pk2(v[j].x, v[j].y); w.y = pk2(v[j].z, v[j].w); o8[64 * j] = w; }
        if (F.lane < 16) part1[(size_t)m * 16 + F.lane] = F.lane == 0 ? s : 0.f;
    }
    {
        const size_t NT = (size_t)F.G * NWAVES * 64, t0 = (size_t)F.vcu * NWAVES * 64 + F.tid;
        constexpr size_t SEGV = 2047 * 64;
        for (size_t i = t0; i < (size_t)128 * SEGV; i += NT) {
            const int seg = (int)(i / SEGV); const size_t off = i - (size_t)seg * SEGV; const int kv = seg >> 6, lb = seg & 63;
            const f32x4* src = (const f32x4*)(F.inp(kv ? I_CV : I_CK)) + (size_t)lb * 131072 + 64 + off;
            f32x4* dst = (f32x4*)(F.out + (kv ? O_VS : O_KS)) + (size_t)lb * 131072 + off;
            __builtin_nontemporal_store(__builtin_nontemporal_load(src), dst);
        }
    }
}

__device__ __forceinline__ int crow(int r, int hi) { return (r & 3) + 8 * (r >> 2) + 4 * hi; }
__device__ __forceinline__ void attn_prompt_task(const bf16* proj, float* atto, float* lse, int task, LAS unsigned char* vbuf, int lane) {
    const int j = task & 63, t2 = task >> 6, cfg = t2 % 3, bh = t2 / 3, h = bh & 3, b = bh >> 2;
    const int sh = 2 * cfg, nqs = 6 - sh, r = j >> nqs, qt = j & ((1 << nqs) - 1);
    const int c = lane & 31, hh = lane >> 5;
    const size_t rowb = (size_t)b * SEQ;
    const float sc2 = 0.125f * 1.4426950408889634f;
    bf16x8 qf[4];
    { const bf16* qp = proj + (rowb + (((32 * qt + c) << sh) + r)) * NPROJ + C_Q + h * 64 + 8 * hh;
#pragma unroll
      for (int s = 0; s < 4; ++s) qf[s] = *(const GAS bf16x8*)(qp + 16 * s); }
    f32x16 O0, O1;
#pragma unroll
    for (int i = 0; i < 16; ++i) { O0[i] = 0.f; O1[i] = 0.f; }
    float mrun = -1e30f, lsum = 0.f;
    const int kt_lo = qt > 4 ? qt - 4 : 0;
    const int trb = (4 * hh + ((lane & 15) >> 2)) * 64 + (16 * ((lane >> 4) & 1) + 4 * (lane & 3)) * 2;
    bf16x8 kfn[4]; v4u vvn[4];
    { const int kt = kt_lo;
      const bf16* kp = proj + (rowb + (((32 * kt + c) << sh) + r)) * NPROJ + C_K + h * 64 + 8 * hh;
#pragma unroll
      for (int s = 0; s < 4; ++s) kfn[s] = *(const GAS bf16x8*)(kp + 16 * s);
#pragma unroll
      for (int i = 0; i < 4; ++i) { const int id = lane + 64 * i, key = id >> 3, ch = id & 7;
          vvn[i] = *(const GAS v4u*)(proj + (rowb + (((32 * kt + key) << sh) + r)) * NPROJ + C_V + h * 64 + ch * 8); } }
    for (int kt = kt_lo; kt <= qt; ++kt) {
        bf16x8 kf[4]; v4u vv[4];
#pragma unroll
        for (int s = 0; s < 4; ++s) { kf[s] = kfn[s]; vv[s] = vvn[s]; }
        if (kt < qt) {
            const bf16* kp = proj + (rowb + (((32 * (kt + 1) + c) << sh) + r)) * NPROJ + C_K + h * 64 + 8 * hh;
#pragma unroll
            for (int s = 0; s < 4; ++s) kfn[s] = *(const GAS bf16x8*)(kp + 16 * s);
#pragma unroll
            for (int i = 0; i < 4; ++i) { const int id = lane + 64 * i, key = id >> 3, ch = id & 7;
                vvn[i] = *(const GAS v4u*)(proj + (rowb + (((32 * (kt + 1) + key) << sh) + r)) * NPROJ + C_V + h * 64 + ch * 8); }
        }
        f32x16 S;
#pragma unroll
        for (int i = 0; i < 16; ++i) S[i] = 0.f;
#pragma unroll
        for (int s = 0; s < 4; ++s) S = __builtin_amdgcn_mfma_f32_32x32x16_bf16(kf[s], qf[s], S, 0, 0, 0);
        float x[16];
        if (kt == qt || kt == qt - 4) {
            const int relb = 32 * (qt - kt) + c;
#pragma unroll
            for (int i = 0; i < 16; ++i) { const int rel = relb - crow(i, hh); x[i] = (rel >= 0 && rel <= 128) ? S[i] * sc2 : -1e30f; }
        } else {
#pragma unroll
            for (int i = 0; i < 16; ++i) x[i] = S[i] * sc2;
        }
        float mx = x[0];
#pragma unroll
        for (int i = 1; i < 16; ++i) mx = fmaxf(mx, x[i]);
        mx = fmaxf(mx, __shfl_xor(mx, 32));
        const float mnew = fmaxf(mrun, mx), alpha = __builtin_amdgcn_exp2f(mrun - mnew);
        mrun = mnew;
        float ps = 0.f;
#pragma unroll
        for (int i = 0; i < 16; ++i) { x[i] = __builtin_amdgcn_exp2f(x[i] - mnew); ps += x[i]; }
        lsum = lsum * alpha + ps;
#pragma unroll
        for (int i = 0; i < 16; ++i) { O0[i] *= alpha; O1[i] *= alpha; }
        bf16x8 pb[2];
#pragma unroll
        for (int s = 0; s < 2; ++s) { v4u w; w.x = pk2(x[8 * s + 0], x[8 * s + 1]); w.y = pk2(x[8 * s + 2], x[8 * s + 3]); w.z = pk2(x[8 * s + 4], x[8 * s + 5]); w.w = pk2(x[8 * s + 6], x[8 * s + 7]); pb[s] = __builtin_bit_cast(bf16x8, w); }
#pragma unroll
        for (int i = 0; i < 4; ++i) { const int id = lane + 64 * i, key = id >> 3, ch = id & 7;
            *(LAS v4u*)(vbuf + (ch >> 2) * 2048 + key * 64 + (ch & 3) * 16) = vv[i]; }
        asm volatile("s_waitcnt lgkmcnt(0)" ::: "memory");
#pragma unroll
        for (int s = 0; s < 2; ++s) {
            const s16x4 a00 = __builtin_bit_cast(s16x4, __builtin_amdgcn_ds_read_tr16_b64_v4i16((LAS s16x4*)(vbuf + trb + (16 * s) * 64)));
            const s16x4 a01 = __builtin_bit_cast(s16x4, __builtin_amdgcn_ds_read_tr16_b64_v4i16((LAS s16x4*)(vbuf + trb + (16 * s + 8) * 64)));
            const s16x4 a10 = __builtin_bit_cast(s16x4, __builtin_amdgcn_ds_read_tr16_b64_v4i16((LAS s16x4*)(vbuf + 2048 + trb + (16 * s) * 64)));
            const s16x4 a11 = __builtin_bit_cast(s16x4, __builtin_amdgcn_ds_read_tr16_b64_v4i16((LAS s16x4*)(vbuf + 2048 + trb + (16 * s + 8) * 64)));
            const bf16x8 A0 = __builtin_shufflevector(a00, a01, 0, 1, 2, 3, 4, 5, 6, 7), A1 = __builtin_shufflevector(a10, a11, 0, 1, 2, 3, 4, 5, 6, 7);
            O0 = __builtin_amdgcn_mfma_f32_32x32x16_bf16(A0, pb[s], O0, 0, 0, 0);
            O1 = __builtin_amdgcn_mfma_f32_32x32x16_bf16(A1, pb[s], O1, 0, 0, 0);
        }
        asm volatile("s_waitcnt lgkmcnt(0)" ::: "memory");
    }
    const float ltot = lsum + __shfl_xor(lsum, 32), inv = 1.0f / ltot;
    const size_t qrow = rowb + (((32 * qt + c) << sh) + r);
    float* op = atto + ((size_t)cfg * MPAD + qrow) * 256 + h * 64 + 4 * hh;
#pragma unroll
    for (int g = 0; g < 4; ++g) {
        *(GAS f32x4*)(op + 8 * g) = (f32x4){O0[4 * g] * inv, O0[4 * g + 1] * inv, O0[4 * g + 2] * inv, O0[4 * g + 3] * inv};
        *(GAS f32x4*)(op + 32 + 8 * g) = (f32x4){O1[4 * g] * inv, O1[4 * g + 1] * inv, O1[4 * g + 2] * inv, O1[4 * g + 3] * inv};
    }
    if (hh == 0) lse[((size_t)cfg * MPAD + qrow) * 4 + h] = mrun * 0.6931471805599453f + __logf(ltot);
}
__device__ __forceinline__ void attn_sample_task(const Frame& F, int l, int s, LAS float* pbuf) {
    const int h = s & 3, b = (s >> 2) & 31, cfg = s >> 7, dil = 1 << (2 * cfg), lane = F.lane;
    const bf16* proj = (const bf16*)(F.ws + WS_PROJ);
    const bf16* prow = proj + (size_t)(MP + b) * NPROJ;
    const float* ck = F.inp(I_CK) + ((size_t)(l * 32 + b) * BUF) * 256 + h * 64;
    const float* cv = F.inp(I_CV) + ((size_t)(l * 32 + b) * BUF) * 256 + h * 64;
    float q[64];
#pragma unroll
    for (int i = 0; i < 8; ++i) unpack8(*(const GAS v4u*)(prow + C_Q + h * 64 + 8 * i), q + 8 * i);
    float sc[3];
#pragma unroll
    for (int it = 0; it < 3; ++it) {
        const int i = lane + 64 * it; float d = 0.f;
        if (i <= 128) {
            if (i == 0) {
#pragma unroll
                for (int u = 0; u < 8; ++u) { float kk[8]; unpack8(*(const GAS v4u*)(prow + C_K + h * 64 + 8 * u), kk);
#pragma unroll
                    for (int e = 0; e < 8; ++e) d += q[8 * u + e] * kk[e]; }
            } else {
                const GAS f32x4* kr = (const GAS f32x4*)(ck + (size_t)(BUF - i * dil) * 256);
#pragma unroll
                for (int u = 0; u < 16; ++u) { const f32x4 kk = kr[u]; d += (q[4 * u] * kk.x + q[4 * u + 1] * kk.y) + (q[4 * u + 2] * kk.z + q[4 * u + 3] * kk.w); }
            }
            sc[it] = d * 0.125f;
        } else sc[it] = -1e30f;
    }
    const float m = wave_max(fmaxf(fmaxf(sc[0], sc[1]), sc[2]));
    float den = 0.f;
#pragma unroll
    for (int it = 0; it < 3; ++it) { const int i = lane + 64 * it; const float p = (i <= 128) ? __expf(sc[it] - m) : 0.f; den += p; if (i <= 128) pbuf[i] = p; }
    den = wave_sum(den);
    asm volatile("s_waitcnt lgkmcnt(0)" ::: "memory");
    float o = pbuf[0] * bflo((unsigned)prow[C_V + h * 64 + lane]);
    for (int i = 1; i <= 128; ++i) o += pbuf[i] * cv[(size_t)(BUF - i * dil) * 256 + lane];
    asm volatile("s_waitcnt lgkmcnt(0)" ::: "memory");
    float* atto = (float*)(F.ws + WS_ATTO); float* lse = (float*)(F.ws + WS_LSE);
    atto[((size_t)cfg * MPAD + MP + b) * 256 + h * 64 + lane] = o / den;
    if (lane == 0) lse[((size_t)cfg * MPAD + MP + b) * 4 + h] = m + __logf(den);
}
__device__ __forceinline__ void attn_phase(Frame F, int l) {
    launder(F); asm volatile("" : "+s"(l));
    const bf16* proj = (const bf16*)(F.ws + WS_PROJ); float* atto = (float*)(F.ws + WS_ATTO); float* lse = (float*)(F.ws + WS_LSE);
    const int gw = F.vcu * NWAVES + F.wave, NGW = F.G * NWAVES;
    LAS unsigned char* vbuf = F.lds + RING_OFF + F.wave * 8192;
    for (int t = gw; t < NB * 4 * 3 * 64; t += NGW) attn_prompt_task(proj, atto, lse, t, vbuf, F.lane);
    for (int s = gw; s < 3 * 32 * 4; s += NGW) attn_sample_task(F, l, s, (LAS float*)(vbuf + 4096));
}

__device__ __forceinline__ void mixer_prompt_tile(Frame& F, int l, int tile) {
    const bf16* proj = (const bf16*)(F.ws + WS_PROJ); bf16* mix = (bf16*)(F.ws + WS_MIX);
    const float* atto = (const float*)(F.ws + WS_ATTO); const float* lse = (const float*)(F.ws + WS_LSE);
    const int b = tile >> 6, t0 = (tile & 63) * 32, tid = F.tid, lane = F.lane;
    const size_t rowb = (size_t)b * SEQ;
    LAS float* ga = (LAS float*)(F.lds + RING_OFF);
    LAS float* yp = ga + 62 * 256;
    for (int it = tid; it < 62 * 32; it += NWAVES * 64) {
        const int rr = it >> 5, ch = it & 31, t = t0 - 30 + rr;
        float g8[8];
        if (t >= 0) { float a8[8], s8[8]; const bf16* pr = proj + (rowb + t) * NPROJ + ch * 8;
            unpack8(*(const GAS v4u*)(pr + C_AV), a8); unpack8(*(const GAS v4u*)(pr + C_AG), s8);
#pragma unroll
            for (int e = 0; e < 8; ++e) g8[e] = a8[e] * sigmoidf_(s8[e]);
        } else {
#pragma unroll
            for (int e = 0; e < 8; ++e) g8[e] = 0.f; }
        *(LAS f32x4*)(ga + rr * 256 + ch * 8) = (f32x4){g8[0], g8[1], g8[2], g8[3]}; *(LAS f32x4*)(ga + rr * 256 + ch * 8 + 4) = (f32x4){g8[4], g8[5], g8[6], g8[7]};
        if (t0 == SEQ - 32 && rr >= 32) { float* d = F.out + O_AP + ((size_t)(l * NB + b) * 30 + (rr - 32)) * 256 + ch * 8;
            *(GAS f32x4*)d = (f32x4){g8[0], g8[1], g8[2], g8[3]}; *(GAS f32x4*)(d + 4) = (f32x4){g8[4], g8[5], g8[6], g8[7]}; }
    }
    __syncthreads();
    {
        const int c = tid & 255, half = tid >> 8;
        const float* cw = F.inp(I_CAW) + (size_t)l * 31 * 256 + c;
        float w[31];
#pragma unroll
        for (int jj = 0; jj < 31; ++jj) w[jj] = cw[jj * 256];
        const float bias = F.inp(I_CAB)[l * 256 + c];
        float acc[16];
#pragma unroll
        for (int t = 0; t < 16; ++t) acc[t] = bias;
#pragma unroll
        for (int rr = 0; rr < 46; ++rr) { const float v = ga[(half * 16 + rr) * 256 + c];
#pragma unroll
            for (int t = 0; t < 16; ++t) { const int jj = rr - t; if (jj >= 0 && jj <= 30) acc[t] += w[jj] * v; } }
#pragma unroll
        for (int t = 0; t < 16; ++t) yp[(half * 16 + t) * 256 + c] = acc[t];
    }
    __syncthreads();
    {
        const f32x4 g4 = *(const GAS f32x4*)(F.inp(I_LNG) + l * 256 + 4 * lane), b4 = *(const GAS f32x4*)(F.inp(I_LNB) + l * 256 + 4 * lane);
#pragma unroll
        for (int tt = 0; tt < 4; ++tt) { const int tok = F.wave * 4 + tt;
            const f32x4 xv = *(LAS f32x4*)(yp + tok * 256 + 4 * lane);
            const float mean = wave_sum((xv.x + xv.y) + (xv.z + xv.w)) * (1.f / 256.f);
            const f32x4 d = xv - mean;
            const float var = wave_sum((d.x * d.x + d.y * d.y) + (d.z * d.z + d.w * d.w)) * (1.f / 256.f);
            const float rstd = __builtin_amdgcn_rsqf(var + EPSN);
            f32x4 y = d * rstd * g4 + b4;
            y.x *= sigmoidf_(y.x); y.y *= sigmoidf_(y.y); y.z *= sigmoidf_(y.z); y.w *= sigmoidf_(y.w);
            v2u w; w.x = pk2(y.x, y.y); w.y = pk2(y.z, y.w);
            *(GAS v2u*)(mix + (rowb + t0 + tok) * DM + 4 * lane) = w; }
    }
    for (int it = tid; it < 32 * 32; it += NWAVES * 64) {
        const int tok = it >> 5, ch = it & 31, t = t0 + tok; const size_t row = rowb + t;
        const bf16* pr = proj + row * NPROJ + ch * 8;
        {
            float cb8[8], cx[3][8];
            unpack8(*(const GAS v4u*)(pr + C_CB), cb8);
#pragma unroll
            for (int k = 0; k < 3; ++k) {
                if (t - k >= 0) { float a8[8], c8[8]; unpack8(*(const GAS v4u*)(pr - (size_t)k * NPROJ + C_CX), a8); unpack8(*(const GAS v4u*)(pr - (size_t)k * NPROJ + C_CC), c8);
#pragma unroll
                    for (int e = 0; e < 8; ++e) cx[k][e] = a8[e] * c8[e];
                } else {
#pragma unroll
                    for (int e = 0; e < 8; ++e) cx[k][e] = 0.f; } }
            const float* cw = F.inp(I_CCW) + (size_t)l * 3 * 256 + ch * 8;
            float o[8];
#pragma unroll
            for (int e = 0; e < 8; ++e) o[e] = cb8[e] * (cw[e] * cx[2][e] + cw[256 + e] * cx[1][e] + cw[512 + e] * cx[0][e]);
            *(GAS v4u*)(mix + row * DM + 512 + ch * 8) = pack8(o);
            if (t >= SEQ - 2) { float* d = F.out + O_CP + ((size_t)(l * NB + b) * 2 + (t - (SEQ - 2))) * 256 + ch * 8;
                *(GAS f32x4*)d = (f32x4){cx[0][0], cx[0][1], cx[0][2], cx[0][3]}; *(GAS f32x4*)(d + 4) = (f32x4){cx[0][4], cx[0][5], cx[0][6], cx[0][7]}; }
        }
        {
            const int w = 2 << (ch >> 3);
            float u0[8], s8[8];
            unpack8(*(const GAS v4u*)(pr + C_DU), u0);
#pragma unroll
            for (int e = 0; e < 8; ++e) s8[e] = u0[e];
            for (int k = 1; k < w; ++k) if (t - k >= 0) { float uk[8]; unpack8(*(const GAS v4u*)(pr - (size_t)k * NPROJ + C_DU), uk);
#pragma unroll
                for (int e = 0; e < 8; ++e) s8[e] += uk[e]; }
            const float cnt = (float)(w < t + 1 ? w : t + 1), ic = 1.0f / cnt;
            float o[8];
#pragma unroll
            for (int e = 0; e < 8; ++e) o[e] = s8[e] * ic - u0[e];
            *(GAS v4u*)(mix + row * DM + 768 + ch * 8) = pack8(o);
            if (t >= SEQ - 15) { float* d = F.out + O_PP + ((size_t)(l * NB + b) * 15 + (t - (SEQ - 15))) * 256 + ch * 8;
                *(GAS f32x4*)d = (f32x4){u0[0], u0[1], u0[2], u0[3]}; *(GAS f32x4*)(d + 4) = (f32x4){u0[4], u0[5], u0[6], u0[7]}; }
        }
        {
            const int h = ch >> 3;
            const float l0 = lse[((size_t)0 * MPAD + row) * 4 + h], l1 = lse[((size_t)1 * MPAD + row) * 4 + h], l2 = lse[((size_t)2 * MPAD + row) * 4 + h];
            const float mx = fmaxf(fmaxf(l0, l1), l2);
            float e0 = __expf(l0 - mx), e1 = __expf(l1 - mx), e2 = __expf(l2 - mx); const float inv = 1.0f / (e0 + e1 + e2);
            e0 *= inv; e1 *= inv; e2 *= inv;
            const float* a0 = atto + ((size_t)0 * MPAD + row) * 256 + ch * 8; const float* a1 = a0 + (size_t)MPAD * 256; const float* a2 = a1 + (size_t)MPAD * 256;
            float o[8];
#pragma unroll
            for (int q4 = 0; q4 < 2; ++q4) { const f32x4 x0 = *(const GAS f32x4*)(a0 + 4 * q4), x1 = *(const GAS f32x4*)(a1 + 4 * q4), x2 = *(const GAS f32x4*)(a2 + 4 * q4);
                const f32x4 y = x0 * e0 + x1 * e1 + x2 * e2; o[4 * q4] = y.x; o[4 * q4 + 1] = y.y; o[4 * q4 + 2] = y.z; o[4 * q4 + 3] = y.w; }
            *(GAS v4u*)(mix + row * DM + 256 + ch * 8) = pack8(o);
        }
    }
    __syncthreads();
}
__device__ __forceinline__ void mixer_sample_row(Frame& F, int l, int b) {
    const bf16* proj = (const bf16*)(F.ws + WS_PROJ); bf16* mix = (bf16*)(F.ws + WS_MIX);
    const float* atto = (const float*)(F.ws + WS_ATTO); const float* lse = (const float*)(F.ws + WS_LSE);
    const int lane = F.lane, c4 = 4 * lane; const size_t row = MP + b;
    const bf16* pr = proj + row * NPROJ + c4;
    auto ld4 = [&](int col, float* f) { const v2u w = *(const GAS v2u*)(pr + col); f[0] = bflo(w.x); f[1] = bfhi(w.x); f[2] = bflo(w.y); f[3] = bfhi(w.y); };
    auto st4 = [&](int col, const float* f) { v2u w; w.x = pk2(f[0], f[1]); w.y = pk2(f[2], f[3]); *(GAS v2u*)(mix + row * DM + col + c4) = w; };
    {
        float a[4], g[4], gn[4]; ld4(C_AV, a); ld4(C_AG, g);
#pragma unroll
        for (int e = 0; e < 4; ++e) gn[e] = a[e] * sigmoidf_(g[e]);
        const float* st = F.inp(I_SA) + ((size_t)(l * 32 + b) * 30) * 256 + c4;
        const float* cw = F.inp(I_CAW) + (size_t)l * 31 * 256 + c4;
        float* so = F.out + O_AS + ((size_t)(l * 32 + b) * 30) * 256 + c4;
        f32x4 acc = *(const GAS f32x4*)(F.inp(I_CAB) + l * 256 + c4);
        for (int jj = 0; jj < 30; ++jj) { const f32x4 sv = *(const GAS f32x4*)(st + jj * 256), wv = *(const GAS f32x4*)(cw + jj * 256); acc += sv * wv; if (jj >= 1) *(GAS f32x4*)(so + (jj - 1) * 256) = sv; }
        const f32x4 wl = *(const GAS f32x4*)(cw + 30 * 256), gv = (f32x4){gn[0], gn[1], gn[2], gn[3]};
        acc += wl * gv; *(GAS f32x4*)(so + 29 * 256) = gv;
        const float mean = wave_sum((acc.x + acc.y) + (acc.z + acc.w)) * (1.f / 256.f);
        const f32x4 d = acc - mean;
        const float var = wave_sum((d.x * d.x + d.y * d.y) + (d.z * d.z + d.w * d.w)) * (1.f / 256.f);
        const float rstd = __builtin_amdgcn_rsqf(var + EPSN);
        const f32x4 g4 = *(const GAS f32x4*)(F.inp(I_LNG) + l * 256 + c4), b4 = *(const GAS f32x4*)(F.inp(I_LNB) + l * 256 + c4);
        f32x4 y = d * rstd * g4 + b4;
        float o[4] = {y.x * sigmoidf_(y.x), y.y * sigmoidf_(y.y), y.z * sigmoidf_(y.z), y.w * sigmoidf_(y.w)};
        st4(0, o);
    }
    {
        float x[4], cb[4], cc[4]; ld4(C_CX, x); ld4(C_CB, cb); ld4(C_CC, cc);
        const float* st = F.inp(I_SC) + ((size_t)(l * 32 + b) * 2) * 256 + c4;
        const float* cw = F.inp(I_CCW) + (size_t)l * 3 * 256 + c4;
        float* so = F.out + O_CS + ((size_t)(l * 32 + b) * 2) * 256 + c4;
        const f32x4 s0 = *(const GAS f32x4*)st, s1 = *(const GAS f32x4*)(st + 256), w0 = *(const GAS f32x4*)cw, w1 = *(const GAS f32x4*)(cw + 256), w2 = *(const GAS f32x4*)(cw + 512);
        const f32x4 cxn = (f32x4){x[0] * cc[0], x[1] * cc[1], x[2] * cc[2], x[3] * cc[3]};
        const f32x4 y = (f32x4){cb[0], cb[1], cb[2], cb[3]} * (w0 * s0 + w1 * s1 + w2 * cxn);
        *(GAS f32x4*)so = s1; *(GAS f32x4*)(so + 256) = cxn;
        float o[4] = {y.x, y.y, y.z, y.w}; st4(512, o);
    }
    {
        float u[4]; ld4(C_DU, u);
        const float* st = F.inp(I_SP) + ((size_t)(l * 32 + b) * 15) * 256 + c4;
        float* so = F.out + O_PS + ((size_t)(l * 32 + b) * 15) * 256 + c4;
        const int w = 2 << (lane >> 4);
        f32x4 s = (f32x4){u[0], u[1], u[2], u[3]};
        for (int jj = 0; jj < 15; ++jj) { const f32x4 sv = *(const GAS f32x4*)(st + jj * 256); if (15 - jj < w) s += sv; if (jj >= 1) *(GAS f32x4*)(so + (jj - 1) * 256) = sv; }
        *(GAS f32x4*)(so + 14 * 256) = (f32x4){u[0], u[1], u[2], u[3]};
        const float iw = 1.0f / (float)w;
        float o[4] = {s.x * iw - u[0], s.y * iw - u[1], s.z * iw - u[2], s.w * iw - u[3]}; st4(768, o);
    }
    {
        const int h = lane >> 4;
        const float l0 = lse[((size_t)0 * MPAD + row) * 4 + h], l1 = lse[((size_t)1 * MPAD + row) * 4 + h], l2 = lse[((size_t)2 * MPAD + row) * 4 + h];
        const float mx = fmaxf(fmaxf(l0, l1), l2);
        float e0 = __expf(l0 - mx), e1 = __expf(l1 - mx), e2 = __expf(l2 - mx); const float inv = 1.0f / (e0 + e1 + e2);
        e0 *= inv; e1 *= inv; e2 *= inv;
        const float* a0 = atto + ((size_t)0 * MPAD + row) * 256 + c4;
        const f32x4 y = *(const GAS f32x4*)a0 * e0 + *(const GAS f32x4*)(a0 + (size_t)MPAD * 256) * e1 + *(const GAS f32x4*)(a0 + (size_t)2 * MPAD * 256) * e2;
        float o[4] = {y.x, y.y, y.z, y.w}; st4(256, o);
    }
}
__device__ __forceinline__ void mixer_phase(Frame F, int l) {
    launder(F); asm volatile("" : "+s"(l));
    for (int tile = F.vcu; tile < NB * 64; tile += F.G) mixer_prompt_tile(F, l, tile);
    const int gw = F.vcu * NWAVES + F.wave, NGW = F.G * NWAVES;
    for (int b = gw; b < MS; b += NGW) mixer_sample_row(F, l, b);
}
__device__ __forceinline__ void final_phase(Frame F) {
    launder(F);
    const bf16* X = (const bf16*)(F.ws + WS_XB); const float* part = (const float*)(F.ws + WS_PART1);
    const int gw = F.vcu * NWAVES + F.wave, NGW = F.G * NWAVES;
    for (int m = gw; m < MP + MS; m += NGW) {
        const float pv = F.lane < 16 ? part[(size_t)m * 16 + F.lane] : 0.f;
        const float rs = __builtin_amdgcn_rsqf(wave_sum(pv) * (1.0f / 1024.0f) + EPSN);
        float* o = m < MP ? F.out + O_Y + (size_t)m * DM : F.out + O_YS + (size_t)(m - MP) * DM;
#pragma unroll
        for (int j = 0; j < 4; ++j) { const v2u b = ((const GAS v2u*)(X + (size_t)m * DM))[F.lane + 64 * j]; const f32x4 g = ((const GAS f32x4*)F.inp(I_FG))[F.lane + 64 * j];
            ((GAS f32x4*)o)[F.lane + 64 * j] = (f32x4){bflo(b.x), bfhi(b.x), bflo(b.y), bfhi(b.y)} * rs * g; }
    }
}
template <int NH, int KW>
__device__ __forceinline__ void mini_gemm(const bf16* A, int lda, const bf16* B0, const bf16* B1, int ldb, LAS float* red, int tid, f32x4 (&res)[NH]) {
    const int lane = tid & 63, wave = __builtin_amdgcn_readfirstlane(tid >> 6), c = lane & 31, hh = lane >> 5, k0 = wave * KW;
    constexpr int NBLK = 2 * NH, W = 64 * NH;
    f32x16 acc[NBLK];
#pragma unroll
    for (int nb = 0; nb < NBLK; ++nb)
#pragma unroll
        for (int i = 0; i < 16; ++i) acc[nb][i] = 0.f;
    const bf16* ap = A + (size_t)c * lda + k0 + 8 * hh;
    const bf16* bp[NBLK];
#pragma unroll
    for (int nb = 0; nb < NBLK; ++nb) bp[nb] = (nb < 2 ? B0 + (size_t)(32 * nb + c) * ldb : B1 + (size_t)(32 * (nb - 2) + c) * ldb) + k0 + 8 * hh;
#pragma unroll 2
    for (int s = 0; s < KW / 16; ++s) {
        const bf16x8 a = *(const GAS bf16x8*)(ap + 16 * s);
#pragma unroll
        for (int nb = 0; nb < NBLK; ++nb) { const bf16x8 b = *(const GAS bf16x8*)(bp[nb] + 16 * s); acc[nb] = __builtin_amdgcn_mfma_f32_32x32x16_bf16(a, b, acc[nb], 0, 0, 0); }
    }
#pragma unroll
    for (int nb = 0; nb < NBLK; ++nb)
#pragma unroll
        for (int i = 0; i < 16; ++i) red[(wave * 32 + crow(i, hh)) * W + 32 * nb + c] = acc[nb][i];
    __syncthreads();
    const int row = tid >> 4, c4 = (tid & 15) * 4;
#pragma unroll
    for (int h = 0; h < NH; ++h) { f32x4 v = (f32x4){0.f, 0.f, 0.f, 0.f};
#pragma unroll
        for (int w = 0; w < 8; ++w) v += *(LAS f32x4*)(red + (w * 32 + row) * W + 64 * h + c4);
        res[h] = v; }
    __syncthreads();
}
__device__ __forceinline__ float row_rs16(const float* part, int row) {
    const GAS f32x4* p = (const GAS f32x4*)(part + (size_t)row * 16);
    const f32x4 a = p[0], b = p[1], c = p[2], d = p[3];
    const float s = ((a.x + a.y) + (a.z + a.w)) + ((b.x + b.y) + (b.z + b.w)) + ((c.x + c.y) + (c.z + c.w)) + ((d.x + d.y) + (d.z + d.w));
    return __builtin_amdgcn_rsqf(s * (1.0f / 1024.0f) + EPSN);
}
__device__ __forceinline__ void sample_inproj(const Frame& F, int l) {
    const bf16* wl = (const bf16*)(F.ws + WS_W + (size_t)l * W_LAYER) + W_IN / 2;
    const int row = F.tid >> 4, c4 = (F.tid & 15) * 4;
    for (int j = F.G - 1 - (int)blockIdx.x; j < NPROJ / 64; j += F.G) {
        f32x4 res[1];
        mini_gemm<1, DM / 8>((const bf16*)(F.ws + WS_XB) + (size_t)MP * DM, DM, wl + (size_t)(64 * j) * DM, nullptr, DM, (LAS float*)(F.lds + RING_OFF), F.tid, res);
        const float r = row_rs16((const float*)(F.ws + WS_PART1), MP + row);
        const f32x4 v = res[0] * r; const int col = 64 * j + c4;
        v2u w; w.x = pk2(v.x, v.y); w.y = pk2(v.z, v.w);
        *(GAS v2u*)((bf16*)(F.ws + WS_PROJ) + (size_t)(MP + row) * NPROJ + col) = w;
        if (col >= C_K && col < C_K + 512) {
            float* d = F.out + (col < C_V ? O_KS : O_VS) + (size_t)l * 32 * BUF * 256 + ((size_t)row * BUF + (BUF - 1)) * 256 + (col & 255);
            *(GAS f32x4*)d = v; }
    }
}
template <int KW>
__device__ __forceinline__ void sample_res(const Frame& F, const bf16* A, int lda, const bf16* Bt, const bf16* base, bf16* xo, float* part) {
    const int row = F.tid >> 4, c4 = (F.tid & 15) * 4;
    for (int j = F.G - 1 - (int)blockIdx.x; j < DM / 64; j += F.G) {
        f32x4 res[1];
        mini_gemm<1, KW>(A + (size_t)MP * lda, lda, Bt + (size_t)(64 * j) * lda, nullptr, lda, (LAS float*)(F.lds + RING_OFF), F.tid, res);
        const size_t off = (size_t)(MP + row) * DM + 64 * j + c4;
        const v2u b = *(const GAS v2u*)(base + off);
        const f32x4 v = res[0] + (f32x4){bflo(b.x), bfhi(b.x), bflo(b.y), bfhi(b.y)};
        v2u w; w.x = pk2(v.x, v.y); w.y = pk2(v.z, v.w);
        *(GAS v2u*)(xo + off) = w;
        float ss = (v.x * v.x + v.y * v.y) + (v.z * v.z + v.w * v.w);
        ss += __shfl_xor(ss, 1); ss += __shfl_xor(ss, 2); ss += __shfl_xor(ss, 4); ss += __shfl_xor(ss, 8);
        if ((F.tid & 15) == 0) part[(size_t)(MP + row) * 16 + j] = ss;
    }
}
__device__ __forceinline__ void sample_gateup(const Frame& F, int l) {
    const bf16* wl = (const bf16*)(F.ws + WS_W + (size_t)l * W_LAYER) + W_GU / 2;
    const int row = F.tid >> 4, c4 = (F.tid & 15) * 4;
    for (int j = F.G - 1 - (int)blockIdx.x; j < FFD / 64; j += F.G) {
        f32x4 res[2]; const int pn = j >> 1, half = j & 1;
        mini_gemm<2, DM / 8>((const bf16*)(F.ws + WS_X1B) + (size_t)MP * DM, DM, wl + (size_t)(256 * pn + 64 * half) * DM, wl + (size_t)(256 * pn + 128 + 64 * half) * DM, DM, (LAS float*)(F.lds + RING_OFF), F.tid, res);
        const float r = row_rs16((const float*)(F.ws + WS_PART2), MP + row);
        const f32x4 g = res[0] * r, u = res[1] * r;
        v2u w; w.x = pk2(g.x * sigmoidf_(g.x) * u.x, g.y * sigmoidf_(g.y) * u.y); w.y = pk2(g.z * sigmoidf_(g.z) * u.z, g.w * sigmoidf_(g.w) * u.w);
        *(GAS v2u*)((bf16*)(F.ws + WS_ACT) + (size_t)(MP + row) * FFD + 64 * j + c4) = w;
    }
}

__device__ __forceinline__ void phase_inproj(Frame F, int l) {
    launder(F); asm volatile("" : "+s"(l));
    const bf16* wl = (const bf16*)(F.ws + WS_W + (size_t)l * W_LAYER);
    pg8::Gemm g{(const bf16*)(F.ws + WS_XB), wl + W_IN / 2, MP, NPROJ, DM}; pg8::StaticOrder S; S.init(MP, NPROJ, F.G, (int)blockIdx.x);
    pg8::EpiProj E{(bf16*)(F.ws + WS_PROJ), (const float*)(F.ws + WS_PART1), F.out + O_KP + (size_t)l * MP * 256, F.out + O_VP + (size_t)l * MP * 256, NPROJ};
    pg8::gemm_phase<pg8::EpiProj, pg8::StaticOrder, true, true>(F.lds + RING_OFF, g, S, E, F.tid);
    sample_inproj(F, l);
}
__device__ __forceinline__ void phase_outproj(Frame F, int l) {
    launder(F); asm volatile("" : "+s"(l));
    const bf16* wl = (const bf16*)(F.ws + WS_W + (size_t)l * W_LAYER);
    pg8::Gemm g{(const bf16*)(F.ws + WS_MIX), wl + W_OUT / 2, MP, DM, DM}; pg8::StaticOrder S; S.init(MP, DM, F.G, (int)blockIdx.x);
    pg8::EpiRes E{(const bf16*)(F.ws + WS_XB), (bf16*)(F.ws + WS_X1B), (float*)(F.ws + WS_PART2)};
    pg8::gemm_phase<pg8::EpiRes, pg8::StaticOrder, true, true>(F.lds + RING_OFF, g, S, E, F.tid);
    sample_res<DM / 8>(F, (const bf16*)(F.ws + WS_MIX), DM, wl + W_OUT / 2, (const bf16*)(F.ws + WS_XB), (bf16*)(F.ws + WS_X1B), (float*)(F.ws + WS_PART2));
}
__device__ __forceinline__ void phase_gateup(Frame F, int l) {
    launder(F); asm volatile("" : "+s"(l));
    const bf16* wl = (const bf16*)(F.ws + WS_W + (size_t)l * W_LAYER);
    pg8::Gemm g{(const bf16*)(F.ws + WS_X1B), wl + W_GU / 2, MP, NGU, DM}; pg8::StaticOrder S; S.init(MP, NGU, F.G, (int)blockIdx.x);
    pg8::EpiSwiGLU E{(bf16*)(F.ws + WS_ACT), (const float*)(F.ws + WS_PART2), FFD};
    pg8::gemm_phase<pg8::EpiSwiGLU, pg8::StaticOrder, true, true>(F.lds + RING_OFF, g, S, E, F.tid);
    sample_gateup(F, l);
}
template <int MODE>
__device__ __forceinline__ void phase_gateup_probe(Frame F, int l) {
    launder(F); asm volatile("" : "+s"(l));
    const bf16* wl = (const bf16*)(F.ws + WS_W + (size_t)l * W_LAYER);
    pg8::Gemm g{(const bf16*)(F.ws + WS_X1B), wl + W_GU / 2, MP, NGU, DM}; pg8::StaticOrder S; S.init(MP, NGU, F.G, (int)blockIdx.x);
    pg8::EpiSwiGLU_<MODE> E{(bf16*)(F.ws + WS_MIX), (const float*)(F.ws + WS_PART2), FFD};
    pg8::gemm_phase<pg8::EpiSwiGLU_<MODE>, pg8::StaticOrder, true, true>(F.lds + RING_OFF, g, S, E, F.tid);
}
__device__ __forceinline__ void phase_down(Frame F, int l) {
    launder(F); asm volatile("" : "+s"(l));
    const bf16* wl = (const bf16*)(F.ws + WS_W + (size_t)l * W_LAYER);
    pg8::Gemm g{(const bf16*)(F.ws + WS_ACT), wl + W_DN / 2, MP, DM, FFD}; pg8::StaticOrder S; S.init(MP, DM, F.G, (int)blockIdx.x);
    pg8::EpiRes E{(const bf16*)(F.ws + WS_X1B), (bf16*)(F.ws + WS_XB), (float*)(F.ws + WS_PART1)};
    pg8::gemm_phase<pg8::EpiRes, pg8::StaticOrder, true, true>(F.lds + RING_OFF, g, S, E, F.tid);
    sample_res<FFD / 8>(F, (const bf16*)(F.ws + WS_ACT), FFD, wl + W_DN / 2, (const bf16*)(F.ws + WS_X1B), (bf16*)(F.ws + WS_XB), (float*)(F.ws + WS_PART1));
}

__global__ void __launch_bounds__(NWAVES * 64, 2) fwd_megakernel(Args args) {
    extern __shared__ __attribute__((aligned(16))) unsigned char lds[];
    Frame F;
    F.lds = (LAS unsigned char*)lds;
    F.tid = threadIdx.x; F.lane = F.tid & 63; F.wave = __builtin_amdgcn_readfirstlane(F.tid >> 6);
    F.G = gridDim.x; { const int bx = blockIdx.x; F.vcu = (F.G % 8 == 0) ? (bx % 8) * (F.G / 8) + bx / 8 : bx; }
    F.ka = (kaptr_t)__builtin_amdgcn_kernarg_segment_ptr();
    F.out = args.out; F.ws = args.ws;
    for (int u = F.tid; u < (LDS_BYTES - LDSCTL_OFF) / 4; u += NWAVES * 64) ((LAS unsigned*)(F.lds + LDSCTL_OFF))[u] = 0u;
    __syncthreads();
    XcdBarrier bar = xcd_barrier_post((unsigned*)(F.ws + WS_CTL) + CW_BAR, (volatile LAS unsigned*)(F.lds + MISC_OFF) + 8);
#if defined(DUP) && (DUP & 256)
#define GRID_BAR() do { xcd_barrier(bar); xcd_barrier(bar); } while (0)
#else
#define GRID_BAR() xcd_barrier(bar)
#endif

#if !defined(PH) || (PH & 1)
    p0_prologue(F);
#endif
    GRID_BAR();
#if defined(DUP) && (DUP & 1)
    p0_prologue(F); GRID_BAR();
#endif
#pragma unroll 1
    for (int l = 0; l < DEPTH; ++l) {
#if !defined(PH) || (PH & 2)
        phase_inproj(F, l);
#endif
        GRID_BAR();
#if defined(DUP) && (DUP & 2)
        phase_inproj(F, l); GRID_BAR();
#endif
#if !defined(PH) || (PH & 4)
        attn_phase(F, l);
#endif
        GRID_BAR();
#if defined(DUP) && (DUP & 4)
        attn_phase(F, l); GRID_BAR();
#endif
#if !defined(PH) || (PH & 8)
        mixer_phase(F, l);
#endif
        GRID_BAR();
#if defined(DUP) && (DUP & 8)
        mixer_phase(F, l); GRID_BAR();
#endif
#if !defined(PH) || (PH & 16)
        phase_outproj(F, l);
#endif
        GRID_BAR();
#if defined(DUP) && (DUP & 16)
        if (l == 0) { phase_outproj(F, l); GRID_BAR(); }
#endif
#if !defined(PH) || (PH & 32)
        phase_gateup(F, l);
#endif
        GRID_BAR();
#if defined(DUP) && (DUP & 32)
        phase_gateup(F, l); GRID_BAR();
#endif
#if defined(DUP) && (DUP & 512)
        phase_gateup_probe<1>(F, l); GRID_BAR();
#endif
#if defined(DUP) && (DUP & 1024)
        phase_gateup_probe<2>(F, l); GRID_BAR();
#endif
#if !defined(PH) || (PH & 64)
        phase_down(F, l);
#endif
        GRID_BAR();
    }
#if !defined(PH) || (PH & 128)
    final_phase(F);
#endif
#if defined(DUP) && (DUP & 128)
    GRID_BAR(); final_phase(F);
#endif
}

extern "C" void kernel_launch(void* const* d_in, const int* in_sizes, int n_in, void* d_out, int out_size, void* d_ws, size_t ws_size, hipStream_t stream) {
    static int grid = 0;
    if (grid == 0) {
        if (n_in != 21 || (size_t)out_size != O_END || ws_size < WS_END) { fprintf(stderr, "kernel_launch: unexpected shapes: n_in %d out %d ws %zu\n", n_in, out_size, ws_size); grid = -1; return; }
        int dev = 0, cus = 0, per_cu = 0;
        if (hipGetDevice(&dev) != hipSuccess || hipDeviceGetAttribute(&cus, hipDeviceAttributeMultiprocessorCount, dev) != hipSuccess) { fprintf(stderr, "kernel_launch: device query failed\n"); grid = -1; return; }
        if (hipFuncSetAttribute((const void*)fwd_megakernel, hipFuncAttributeMaxDynamicSharedMemorySize, LDS_BYTES) != hipSuccess) { fprintf(stderr, "kernel_launch: hipFuncSetAttribute failed\n"); grid = -1; return; }
        if (hipOccupancyMaxActiveBlocksPerMultiprocessor(&per_cu, (const void*)fwd_megakernel, NWAVES * 64, LDS_BYTES) != hipSuccess || per_cu < 1) { fprintf(stderr, "kernel_launch: occupancy query says %d blocks per CU\n", per_cu); grid = -1; (void)hipGetLastError(); return; }
        grid = cus;
    }
    if (grid < 0) return;
    if (hipMemsetAsync((char*)d_ws + WS_CTL, 0, CTL_ZERO_BYTES, stream) != hipSuccess) { fprintf(stderr, "kernel_launch: memset failed\n"); return; }
    Args a{};
    for (int i = 0; i < 21; ++i) a.in[i] = (const float*)d_in[i];
    a.out = (float*)d_out; a.ws = (unsigned char*)d_ws;
    void* kargs[] = {&a};
    hipError_t e = hipLaunchCooperativeKernel((const void*)fwd_megakernel, dim3(grid), dim3(NWAVES * 64), kargs, LDS_BYTES, stream);
    if (e != hipSuccess) fprintf(stderr, "kernel_launch: cooperative launch failed: %s (grid %d)\n", hipGetErrorString(e), grid);
}
```
